# Optimizing an MI355X kernel written in HIP

```python
import jax, jax.numpy as jnp
from jax import lax
import numpy as np

D_MODEL = 1024
BATCH = 2
SEQ = 8192
DEPTH = 1

CTX_LEN = 256
GRID_W = 64

GLA_HEADS = 4
GLA_DK = 128
GLA_DV = 256
GLA_RANK = 16
GLA_TAU = 16.0
GLA_CHUNK = 64
GLA_QK = GLA_HEADS * GLA_DK
GLA_V = GLA_HEADS * GLA_DV

RET_HEADS = 4
RET_DK = 128
RET_DV = 256
RET_CHUNK = 128
RET_QK = RET_HEADS * RET_DK
RET_V = RET_HEADS * RET_DV
ROPE_BASE = 10000.0

N_GROUPS = 4
EXPERTS_PER_GROUP = 8
N_EXPERTS = N_GROUPS * EXPERTS_PER_GROUP
TOP_K = 2
EXPERT_FF = 256
MOE_BLOCK = 128

NORM_EPS = 1e-6

IN_SPLITS = (GLA_QK, GLA_QK, GLA_V, GLA_V, GLA_RANK, GLA_RANK,
             RET_QK, RET_QK, RET_V, RET_V, D_MODEL, D_MODEL)
IN_WIDTH = sum(IN_SPLITS)

kernel_name = 'hybrid_gla_retention_hmoe_dit_block'


def rmsnorm(x, g):
    xf = x.astype(jnp.float32)
    y = xf * lax.rsqrt(jnp.mean(xf * xf, axis=-1, keepdims=True) + NORM_EPS)
    return (y * g.astype(jnp.float32)).astype(x.dtype)


def head_groupnorm(o):
    of = o.astype(jnp.float32)
    mu = jnp.mean(of, axis=-1, keepdims=True)
    var = jnp.mean(jnp.square(of - mu), axis=-1, keepdims=True)
    return ((of - mu) * lax.rsqrt(var + NORM_EPS)).astype(o.dtype)


def modulate(h, shift, scale):
    return h * (1.0 + scale) + shift


def split_columns(proj):
    out = []
    start = 0
    for w in IN_SPLITS:
        out.append(proj[..., start:start + w])
        start += w
    return out


def retention_log_decays():
    h = jnp.arange(RET_HEADS, dtype=jnp.float32)
    fwd = jnp.log1p(-jnp.exp2(-5.0 - h))
    bwd = jnp.log1p(-jnp.exp2(-5.5 - h))
    return fwd, bwd


def axial_rope(t, rows, cols):
    half = t.shape[-1] // 2
    n = half // 2
    inv = ROPE_BASE ** (-jnp.arange(n, dtype=jnp.float32) / n)

    def rot(u, p):
        ang = p[:, None] * inv[None, :]
        cos = jnp.cos(ang)[None, :, None, :].astype(u.dtype)
        sin = jnp.sin(ang)[None, :, None, :].astype(u.dtype)
        u1, u2 = u[..., :n], u[..., n:]
        return jnp.concatenate([u1 * cos - u2 * sin, u1 * sin + u2 * cos], axis=-1)

    return jnp.concatenate([rot(t[..., :half], rows), rot(t[..., half:], cols)], axis=-1)


def to_chunks(t, chunk):
    B, L, H, W = t.shape
    return jnp.moveaxis(t.reshape(B, L // chunk, chunk, H, W), 1, 0)


def from_chunks(o):
    N, B, C, H, W = o.shape
    return jnp.moveaxis(o, 0, 1).reshape(B, N * C, H, W)


def gla_scan(q, k, v, log_a, s0, strict):
    C = GLA_CHUNK
    ti = jnp.arange(C)
    mask = (ti[:, None] > ti[None, :]) if strict else (ti[:, None] >= ti[None, :])
    mask5 = mask[None, :, :, None, None]

    def step(S, inp):
        qc, kc, vc, lac = inp
        b = jnp.cumsum(lac.astype(jnp.float32), axis=1)
        inter = jnp.einsum('bthk,bhkv->bthv', qc * jnp.exp(b), S)
        decay = jnp.exp(jnp.where(mask5, b[:, :, None] - b[:, None, :], -jnp.inf))
        scores = jnp.einsum('bthk,btshk,bshk->btsh', qc, decay, kc)
        intra = jnp.einsum('btsh,bshv->bthv', scores, vc)
        b_last = b[:, -1]
        S_new = jnp.exp(b_last)[..., None] * S + jnp.einsum(
            'bshk,bshv->bhkv', kc * jnp.exp(b_last[:, None] - b), vc)
        return S_new, inter + intra

    S_fin, o = lax.scan(step, s0, (to_chunks(q, C), to_chunks(k, C), to_chunks(v, C), to_chunks(log_a, C)))
    return from_chunks(o).astype(v.dtype), S_fin


def retention_scan(q, k, v, log_gamma, s0, strict):
    C = RET_CHUNK
    pos = jnp.arange(C, dtype=jnp.float32)
    ti = jnp.arange(C)
    mask = (ti[:, None] > ti[None, :]) if strict else (ti[:, None] >= ti[None, :])
    rel = pos[:, None] - pos[None, :]
    dmat = jnp.exp(jnp.where(mask[None], rel[None] * log_gamma[:, None, None], -jnp.inf))
    q_decay = jnp.exp((pos + 1.0)[:, None] * log_gamma[None, :])
    k_decay = jnp.exp((C - 1.0 - pos)[:, None] * log_gamma[None, :])
    c_decay = jnp.exp(C * log_gamma)

    def step(S, inp):
        qc, kc, vc = inp
        inter = jnp.einsum('bthk,bhkv->bthv', qc, S) * q_decay[None, :, :, None]
        scores = jnp.einsum('bthk,bshk->bhts', qc, kc) * dmat[None]
        intra = jnp.einsum('bhts,bshv->bthv', scores, vc)
        S_new = c_decay[None, :, None, None] * S + jnp.einsum(
            'bshk,bshv->bhkv', kc * k_decay[None, :, :, None], vc)
        return S_new, inter + intra

    S_fin, o = lax.scan(step, s0, (to_chunks(q, C), to_chunks(k, C), to_chunks(v, C)))
    return from_chunks(o).astype(v.dtype), S_fin


def mixer_heads(h, w_in, gla_lr_w, gla_lr_b, gla_norm, states, rope):
    B, L, _ = h.shape
    (gq, gk, gv, gg, glr_f, glr_b, rq, rk, rv, rg, m_gla, m_ret) = split_columns(h @ w_in)

    def heads(t, n):
        return t.reshape(B, L, n, -1)

    def flip(t):
        return jnp.flip(t, axis=1)

    gq = heads(gq, GLA_HEADS) * GLA_DK ** -0.5
    gk = heads(gk, GLA_HEADS)
    gv = heads(gv, GLA_HEADS)

    def log_gate(lr, d):
        z = (lr @ gla_lr_w[d] + gla_lr_b[d]).astype(jnp.float32)
        return heads(jax.nn.log_sigmoid(z) / GLA_TAU, GLA_HEADS)

    o_f, s_gf = gla_scan(gq, gk, gv, log_gate(glr_f, 0), states[0], False)
    o_b, s_gb = gla_scan(flip(gq), flip(gk), flip(gv), flip(log_gate(glr_b, 1)), states[1], True)
    o_gla = rmsnorm(o_f + flip(o_b), gla_norm) * jax.nn.silu(heads(gg, GLA_HEADS))
    o_gla = o_gla.reshape(B, L, GLA_V)

    rq = heads(rq, RET_HEADS)
    rk = heads(rk, RET_HEADS) * RET_DK ** -0.5
    rv = heads(rv, RET_HEADS)
    if rope is not None:
        rq = axial_rope(rq, rope[0], rope[1])
        rk = axial_rope(rk, rope[0], rope[1])
    lg_f, lg_b = retention_log_decays()
    r_f, s_rf = retention_scan(rq, rk, rv, lg_f, states[2], False)
    r_b, s_rb = retention_scan(flip(rq), flip(rk), flip(rv), lg_b, states[3], True)
    o_ret = head_groupnorm(r_f + flip(r_b)) * jax.nn.silu(heads(rg, RET_HEADS))
    o_ret = o_ret.reshape(B, L, RET_V)
    return o_gla, o_ret, m_gla, m_ret, (s_gf, s_gb, s_rf, s_rb)


def merge_branches(o_gla, o_ret, m_gla, m_ret, w_branch_gla, w_branch_ret, w_out):
    y = jax.nn.sigmoid(m_gla) * (o_gla @ w_branch_gla) + jax.nn.sigmoid(m_ret) * (o_ret @ w_branch_ret)
    return y @ w_out


def hier_moe(h, w_rg, b_rg, w_re, b_re, w_gate, w_up, w_down):
    B, L, D = h.shape
    T = B * L
    xt = h.reshape(T, D)
    g_logits = (xt @ w_rg + b_rg).astype(jnp.float32)
    g_prob = jax.nn.softmax(g_logits, axis=-1)
    g_sel = jnp.argmax(g_logits, axis=-1).astype(jnp.int32)
    g_w = jnp.take_along_axis(g_prob, g_sel[:, None], axis=-1)[:, 0]
    e_logits = (xt @ w_re + b_re).astype(jnp.float32).reshape(T, N_GROUPS, EXPERTS_PER_GROUP)
    e_logits = jnp.take_along_axis(e_logits, g_sel[:, None, None], axis=1)[:, 0]
    top_v, top_i = lax.top_k(e_logits, TOP_K)
    e_w = jax.nn.softmax(top_v, axis=-1) * g_w[:, None]
    expert_id = g_sel[:, None] * EXPERTS_PER_GROUP + top_i.astype(jnp.int32)

    A = T * TOP_K
    flat_e = expert_id.reshape(A)
    flat_tok = jnp.repeat(jnp.arange(T, dtype=jnp.int32), TOP_K)
    flat_w = e_w.reshape(A)
    order = jnp.argsort(flat_e)
    se, stok, sw = flat_e[order], flat_tok[order], flat_w[order]
    counts = jax.ops.segment_sum(jnp.ones((A,), jnp.int32), flat_e, num_segments=N_EXPERTS)
    starts = jnp.cumsum(counts) - counts
    padded = (counts + MOE_BLOCK - 1) // MOE_BLOCK * MOE_BLOCK
    pends = jnp.cumsum(padded)
    pstarts = pends - padded
    dest = pstarts[se] + jnp.arange(A, dtype=jnp.int32) - starts[se]
    P = A + N_EXPERTS * MOE_BLOCK
    NB = P // MOE_BLOCK
    x_pad = jnp.zeros((P, D), h.dtype).at[dest].set(xt[stok])
    tok_pad = jnp.zeros((P,), jnp.int32).at[dest].set(stok)
    w_pad = jnp.zeros((P,), jnp.float32).at[dest].set(sw)
    block_start = jnp.arange(NB, dtype=jnp.int32) * MOE_BLOCK
    block_e = jnp.minimum(jnp.searchsorted(pends, block_start, side='right'), N_EXPERTS - 1)

    def expert_block(args):
        xb, e = args
        hid = jax.nn.silu(xb @ w_gate[e]) * (xb @ w_up[e])
        return hid @ w_down[e]

    y = lax.map(expert_block, (x_pad.reshape(NB, MOE_BLOCK, D), block_e)).reshape(P, D)
    out = jnp.zeros((T, D), jnp.float32).at[tok_pad].add(y.astype(jnp.float32) * w_pad[:, None])
    return out.astype(h.dtype).reshape(B, L, D)


def setup_inputs(seed: int = 0) -> dict:
    key = jax.random.key(seed)
    ks = jax.random.split(key, 24)

    def nrm(k, shape, scale):
        return jax.random.normal(k, shape, jnp.float32) * scale

    D = D_MODEL
    return {
        'x': nrm(ks[0], (BATCH, SEQ, D), 1.0),
        'c': nrm(ks[1], (BATCH, D), 1.0),
        'ctx': nrm(ks[2], (BATCH, CTX_LEN, D), 1.0),
        'c_ctx': nrm(ks[3], (D,), 1.0),
        'w_ada': nrm(ks[4], (DEPTH, D, 6 * D), D ** -0.5),
        'b_ada': nrm(ks[5], (DEPTH, 6 * D), 0.02),
        'norm_mix': 1.0 + nrm(ks[6], (DEPTH, D), 0.05),
        'norm_ffn': 1.0 + nrm(ks[7], (DEPTH, D), 0.05),
        'w_in': nrm(ks[8], (DEPTH, D, IN_WIDTH), D ** -0.5),
        'gla_lr_w': nrm(ks[9], (DEPTH, 2, GLA_RANK, GLA_QK), GLA_RANK ** -0.5),
        'gla_lr_b': nrm(ks[10], (DEPTH, 2, GLA_QK), 0.1),
        'gla_norm': 1.0 + nrm(ks[11], (DEPTH, GLA_DV), 0.05),
        'w_branch_gla': nrm(ks[12], (DEPTH, GLA_V, D), GLA_V ** -0.5),
        'w_branch_ret': nrm(ks[13], (DEPTH, RET_V, D), RET_V ** -0.5),
        'w_out': nrm(ks[14], (DEPTH, D, D), D ** -0.5),
        'w_router_group': nrm(ks[15], (DEPTH, D, N_GROUPS), D ** -0.5),
        'b_router_group': nrm(ks[16], (DEPTH, N_GROUPS), 0.01),
        'w_router_expert': nrm(ks[17], (DEPTH, D, N_EXPERTS), D ** -0.5),
        'b_router_expert': nrm(ks[18], (DEPTH, N_EXPERTS), 0.01),
        'w_expert_gate': nrm(ks[19], (DEPTH, N_EXPERTS, D, EXPERT_FF), D ** -0.5),
        'w_expert_up': nrm(ks[20], (DEPTH, N_EXPERTS, D, EXPERT_FF), D ** -0.5),
        'w_expert_down': nrm(ks[21], (DEPTH, N_EXPERTS, EXPERT_FF, D), EXPERT_FF ** -0.5),
        'norm_final': 1.0 + nrm(ks[22], (D,), 0.05),
    }


def reference(x, c, ctx, c_ctx, w_ada, b_ada, norm_mix, norm_ffn, w_in, gla_lr_w, gla_lr_b, gla_norm,
              w_branch_gla, w_branch_ret, w_out, w_router_group, b_router_group, w_router_expert,
              b_router_expert, w_expert_gate, w_expert_up, w_expert_down, norm_final):
    B, L, _ = x.shape
    ROWS = L // GRID_W
    rows = jnp.repeat(jnp.arange(ROWS, dtype=jnp.float32), GRID_W)
    cols = jnp.tile(jnp.arange(GRID_W, dtype=jnp.float32), ROWS)
    zero_states = (
        jnp.zeros((B, GLA_HEADS, GLA_DK, GLA_DV), jnp.float32),
        jnp.zeros((B, GLA_HEADS, GLA_DK, GLA_DV), jnp.float32),
        jnp.zeros((B, RET_HEADS, RET_DK, RET_DV), jnp.float32),
        jnp.zeros((B, RET_HEADS, RET_DK, RET_DV), jnp.float32),
    )
    h_lat = x
    h_ctx = ctx
    for layer in range(DEPTH):
        sh1, sc1, g1, sh2, sc2, g2 = jnp.split(
            (jax.nn.silu(c) @ w_ada[layer] + b_ada[layer])[:, None, :], 6, axis=-1)
        csh1, csc1, cg1, csh2, csc2, cg2 = jnp.split(
            (jax.nn.silu(c_ctx) @ w_ada[layer] + b_ada[layer])[None, None, :], 6, axis=-1)
        mix_args = (w_in[layer], gla_lr_w[layer], gla_lr_b[layer], gla_norm[layer])
        merge_args = (w_branch_gla[layer], w_branch_ret[layer], w_out[layer])
        moe_args = (w_router_group[layer], b_router_group[layer], w_router_expert[layer],
                    b_router_expert[layer], w_expert_gate[layer], w_expert_up[layer], w_expert_down[layer])

        hc = modulate(rmsnorm(h_ctx, norm_mix[layer]), csh1, csc1)
        c_gla, c_ret, c_mg, c_mr, ctx_states = mixer_heads(hc, *mix_args, zero_states, None)

        hl = modulate(rmsnorm(h_lat, norm_mix[layer]), sh1, sc1)
        l_gla, l_ret, l_mg, l_mr, _ = mixer_heads(hl, *mix_args, ctx_states, (rows, cols))
        h_lat = h_lat + g1 * merge_branches(l_gla, l_ret, l_mg, l_mr, *merge_args)
        h_lat = h_lat + g2 * hier_moe(modulate(rmsnorm(h_lat, norm_ffn[layer]), sh2, sc2), *moe_args)

        if layer < DEPTH - 1:
            h_ctx = h_ctx + cg1 * merge_branches(c_gla, c_ret, c_mg, c_mr, *merge_args)
            h_ctx = h_ctx + cg2 * hier_moe(modulate(rmsnorm(h_ctx, norm_ffn[layer]), csh2, csc2), *moe_args)
    return rmsnorm(h_lat, norm_final)
```

```cpp
#include <hip/hip_runtime.h>
#include <stdint.h>
#include <stdio.h>

typedef unsigned short bf16;
__device__ __forceinline__ float bf2f(bf16 v) { return __uint_as_float(((unsigned)v) << 16); }
__device__ __forceinline__ bf16 f2bf(float f) { unsigned u = __float_as_uint(f); return (bf16)((u + 0x7fffu + ((u >> 16) & 1u)) >> 16); }

constexpr int D = 1024, NB = 2, L = 8192, T = NB * L, CTX = 256, TC = NB * CTX, TT = T + TC;
constexpr int INW = 8224;
constexpr float EPS = 1e-6f;
constexpr size_t MiB = 1u << 20;
constexpr size_t WS_CTL = 0;
constexpr size_t WS_ADA = 1 * MiB;
constexpr size_t WS_ROPE = 1 * MiB + 256 * 1024;
constexpr size_t WS_LR = 2 * MiB;
constexpr size_t WS_ROUTE = 5 * MiB;
constexpr size_t WS_SORT = 6 * MiB;
constexpr size_t WS_HL = 8 * MiB;
constexpr size_t WS_GQ = 42 * MiB;
constexpr size_t WS_GK = 58 * MiB;
constexpr size_t WS_RQ = 75 * MiB;
constexpr size_t WS_RK = 91 * MiB;
constexpr size_t WS_GV = 108 * MiB;
constexpr size_t WS_RV = 141 * MiB;
constexpr size_t WS_GG = 174 * MiB;
constexpr size_t WS_RG = 206 * MiB;
constexpr size_t WS_END = 238 * MiB;
constexpr int CW_CNT = 1024;
constexpr int CW_CUR = 1024 + 64;

__global__ void k_ada(const float* c, const float* cctx, const float* w_ada, const float* b_ada, float* ada) {
    int idx = blockIdx.x * 256 + threadIdx.x; if (idx >= 3 * 6144) return;
    int r = idx / 6144, n = idx % 6144;
    const float* cv = r < 2 ? c + r * 1024 : cctx;
    float acc = 0.f;
    for (int k = 0; k < 1024; ++k) { float x = cv[k]; float s = x / (1.f + expf(-x)); acc += s * w_ada[(size_t)k * 6144 + n]; }
    ada[idx] = acc + b_ada[n];
}
__global__ void k_rope_tab(float2* tab) {
    int idx = blockIdx.x * 256 + threadIdx.x; if (idx >= 128 * 32) return;
    int p = idx / 32, j = idx % 32;
    float inv = powf(10000.f, -(float)j / 32.f);
    float ang = (float)p * inv;
    tab[idx] = make_float2(cosf(ang), sinf(ang));
}
__global__ __launch_bounds__(256) void k_norm_mod(const float* x, const float* ctx, const float* gnorm, const float* ada, bf16* hl) {
    int lane = threadIdx.x & 63, gw = (blockIdx.x * blockDim.x + threadIdx.x) >> 6, ngw = (gridDim.x * blockDim.x) >> 6;
    for (int r = gw; r < TT; r += ngw) {
        const float* src = r < T ? x + (size_t)r * D : ctx + (size_t)(r - T) * D;
        int ar = r < T ? r / L : 2;
        const float* sh = ada + ar * 6144; const float* sc = sh + 1024;
        float v[16]; float ss = 0.f;
        for (int j = 0; j < 4; ++j) { float4 t = *(const float4*)(src + j * 256 + lane * 4); v[4*j] = t.x; v[4*j+1] = t.y; v[4*j+2] = t.z; v[4*j+3] = t.w; ss += t.x*t.x + t.y*t.y + t.z*t.z + t.w*t.w; }
        for (int o = 1; o < 64; o <<= 1) ss += __shfl_xor(ss, o);
        float rstd = rsqrtf(ss * (1.f / D) + EPS);
        for (int j = 0; j < 4; ++j) for (int i = 0; i < 4; ++i) { int c = j * 256 + lane * 4 + i; float y = v[4*j+i] * rstd * gnorm[c]; y = y * (1.f + sc[c]) + sh[c]; hl[(size_t)r * D + c] = f2bf(y); }
    }
}
template <class Epi> __global__ __launch_bounds__(256) void k_gemm_naive(const bf16* A, int lda, const float* W, int ldw, int M, int N, int K, Epi epi) {
    __shared__ float As[16][132];
    __shared__ float Ws[16][132];
    int tid = threadIdx.x, tx = tid & 15, ty = tid >> 4;
    int bm = blockIdx.y * 128, bn = blockIdx.x * 128;
    float acc[8][8];
    for (int i = 0; i < 8; ++i) for (int j = 0; j < 8; ++j) acc[i][j] = 0.f;
    for (int k0 = 0; k0 < K; k0 += 16) {
        { int r = tid >> 1, kk = (tid & 1) * 8; const bf16* ap = A + (size_t)(bm + r) * lda + k0 + kk;
          uint4 raw = *(const uint4*)ap; unsigned w[4] = {raw.x, raw.y, raw.z, raw.w};
          for (int i = 0; i < 4; ++i) { As[kk + 2*i][r] = __uint_as_float(w[i] << 16); As[kk + 2*i + 1][r] = __uint_as_float(w[i] & 0xffff0000u); } }
        { int kk = tid >> 4, n = (tid & 15) * 8; const float* wp = W + (size_t)(k0 + kk) * ldw + bn + n;
          for (int i = 0; i < 8; ++i) Ws[kk][n + i] = (bn + n + i < N) ? wp[i] : 0.f; }
        __syncthreads();
#pragma unroll
        for (int kk = 0; kk < 16; ++kk) {
            float a[8], w[8];
#pragma unroll
            for (int i = 0; i < 8; ++i) a[i] = As[kk][ty * 8 + i];
#pragma unroll
            for (int j = 0; j < 8; ++j) w[j] = Ws[kk][tx * 8 + j];
#pragma unroll
            for (int i = 0; i < 8; ++i)
#pragma unroll
                for (int j = 0; j < 8; ++j) acc[i][j] += a[i] * w[j];
        }
        __syncthreads();
    }
#pragma unroll
    for (int i = 0; i < 8; ++i)
#pragma unroll
        for (int j = 0; j < 8; ++j) { int r = bm + ty * 8 + i, c = bn + tx * 8 + j; if (c < N) epi(r, c, acc[i][j]); }
}
struct EpiProj {
    bf16 *GQ, *GK, *GV, *GG, *RQ, *RK, *RV, *RG; float* LR;
    __device__ void operator()(int r, int c, float v) const {
        const float s = 0.08838834764831845f;
        if (c < 512) { if (r < T) GQ[(size_t)r * 512 + c] = f2bf(v * s); }
        else if (c < 1024) GK[(size_t)r * 512 + c - 512] = f2bf(v);
        else if (c < 2048) GV[(size_t)r * 1024 + c - 1024] = f2bf(v);
        else if (c < 3072) { if (r < T) GG[(size_t)r * 1024 + c - 2048] = f2bf(v); }
        else if (c < 3104) LR[(size_t)r * 32 + c - 3072] = v;
        else if (c < 3616) { if (r < T) RQ[(size_t)r * 512 + c - 3104] = f2bf(v); }
        else if (c < 4128) RK[(size_t)r * 512 + c - 3616] = f2bf(v * s);
        else if (c < 5152) RV[(size_t)r * 1024 + c - 4128] = f2bf(v);
        else { if (r < T) RG[(size_t)r * 1024 + c - 5152] = f2bf(v); }
    }
};
struct EpiSig { bf16* S; __device__ void operator()(int r, int c, float v) const { S[(size_t)r * 1024 + c] = f2bf(1.f / (1.f + expf(-v))); } };
struct EpiGate1 { bf16* Y; __device__ void operator()(int r, int c, float v) const { size_t i = (size_t)r * 1024 + c; Y[i] = f2bf(bf2f(Y[i]) * v); } };
struct EpiGate2 { bf16* Y; const bf16* S2; __device__ void operator()(int r, int c, float v) const { size_t i = (size_t)r * 1024 + c; Y[i] = f2bf(bf2f(Y[i]) + bf2f(S2[i]) * v); } };
struct EpiOut { const float* x; const float* ada; float* H1; __device__ void operator()(int r, int c, float v) const { size_t i = (size_t)r * 1024 + c; H1[i] = x[i] + ada[(r / L) * 6144 + 2048 + c] * v; } };

__global__ void k_rope(bf16* RQ, bf16* RK, const float2* tab) {
    size_t idx = (size_t)blockIdx.x * 256 + threadIdx.x;
    if (idx >= (size_t)T * 256) return;
    int j = idx & 31, half = (idx >> 5) & 1, h = (idx >> 6) & 3; int r = (int)(idx >> 8);
    int l = r % L; int pos = half == 0 ? l / 64 : l % 64;
    float2 cs = tab[pos * 32 + j];
    size_t o = (size_t)r * 512 + h * 128 + half * 64 + j;
    { float u1 = bf2f(RQ[o]), u2 = bf2f(RQ[o + 32]); RQ[o] = f2bf(u1 * cs.x - u2 * cs.y); RQ[o + 32] = f2bf(u1 * cs.y + u2 * cs.x); }
    { float u1 = bf2f(RK[o]), u2 = bf2f(RK[o + 32]); RK[o] = f2bf(u1 * cs.x - u2 * cs.y); RK[o + 32] = f2bf(u1 * cs.y + u2 * cs.x); }
}

struct ScanP { const bf16 *GQ, *GK, *GV, *RQ, *RK, *RV; bf16 *GG, *RG; const float *LR, *lrw, *lrb, *gnorm; bf16* OF; };
template <int DIR> __global__ __launch_bounds__(512) void k_scan_naive(ScanP p) {
    const int unit = blockIdx.x, mixer = unit >> 3, b = (unit >> 2) & 1, h = unit & 3;
    const int t = threadIdx.x, w = t >> 6, l = t & 63;
    __shared__ float sq[128], sk[128], sa[128], sv[256], red[8][256], rs[8];
    const bf16* Q = mixer ? p.RQ : p.GQ; const bf16* K = mixer ? p.RK : p.GK; const bf16* V = mixer ? p.RV : p.GV; bf16* G = mixer ? p.RG : p.GG;
    float S[16][4];
    for (int i = 0; i < 16; ++i) for (int j = 0; j < 4; ++j) S[i][j] = 0.f;
    const float gamma = 1.f - exp2f(-(DIR ? 5.5f : 5.0f) - (float)h);
    for (int step = 0; step < CTX + L; ++step) {
        const bool isctx = step < CTX; const int idx = isctx ? step : step - CTX;
        const int tok = DIR == 0 ? idx : (isctx ? CTX - 1 - idx : L - 1 - idx);
        const size_t rkv = isctx ? (size_t)T + b * CTX + tok : (size_t)b * L + tok;
        const size_t rq = (size_t)b * L + tok;
        if (t < 128) {
            sk[t] = bf2f(K[rkv * 512 + h * 128 + t]);
            sq[t] = isctx ? 0.f : bf2f(Q[rq * 512 + h * 128 + t]);
            if (mixer == 0) {
                float z = p.lrb[DIR * 512 + h * 128 + t];
                for (int r = 0; r < 16; ++r) z += p.LR[rkv * 32 + DIR * 16 + r] * p.lrw[(DIR * 16 + r) * 512 + h * 128 + t];
                float ls = fminf(z, 0.f) - log1pf(expf(-fabsf(z)));
                sa[t] = expf(ls * (1.f / 16.f));
            } else sa[t] = gamma;
        } else if (t < 384) sv[t - 128] = bf2f(V[rkv * 1024 + h * 256 + t - 128]);
        __syncthreads();
        float o[4] = {0.f, 0.f, 0.f, 0.f}; float v[4] = {sv[4 * l], sv[4 * l + 1], sv[4 * l + 2], sv[4 * l + 3]};
        for (int i = 0; i < 16; ++i) { const int dk = 16 * w + i; const float a = sa[dk], kk = sk[dk], qq = sq[dk];
            for (int j = 0; j < 4; ++j) {
                if (DIR == 0) { S[i][j] = a * S[i][j] + kk * v[j]; o[j] += qq * S[i][j]; }
                else { float sp = a * S[i][j]; o[j] += qq * sp; S[i][j] = sp + kk * v[j]; } } }
        if (!isctx) {
            for (int j = 0; j < 4; ++j) red[w][4 * l + j] = o[j];
            __syncthreads();
            float ot = 0.f;
            if (t < 256) { for (int i = 0; i < 8; ++i) ot += red[i][t]; }
            if (DIR == 0) { if (t < 256) p.OF[rq * 2048 + mixer * 1024 + h * 256 + t] = f2bf(ot); }
            else {
                if (t < 256) ot += bf2f(p.OF[rq * 2048 + mixer * 1024 + h * 256 + t]);
                float s1 = t < 256 ? ot : 0.f; for (int o2 = 1; o2 < 64; o2 <<= 1) s1 += __shfl_xor(s1, o2);
                if (l == 0) rs[w] = s1; __syncthreads();
                const float mu = (rs[0] + rs[1] + rs[2] + rs[3]) * (1.f / 256.f); __syncthreads();
                const float dv = mixer ? ot - mu : ot;
                float s2 = t < 256 ? dv * dv : 0.f; for (int o2 = 1; o2 < 64; o2 <<= 1) s2 += __shfl_xor(s2, o2);
                if (l == 0) rs[w] = s2; __syncthreads();
                const float var = (rs[0] + rs[1] + rs[2] + rs[3]) * (1.f / 256.f);
                if (t < 256) { float y = dv * rsqrtf(var + EPS); if (mixer == 0) y *= p.gnorm[t];
                    const size_t gi = rq * 1024 + h * 256 + t; const float g = bf2f(G[gi]); y *= g / (1.f + expf(-g)); G[gi] = f2bf(y); }
            }
        }
        __syncthreads();
    }
}

struct RouteP { const float *H1, *gnorm, *ada, *wrg, *brg, *wre, *bre; bf16* H2; int4* route; float2* rw; unsigned* cnt; };
__global__ __launch_bounds__(256) void k_norm_route(RouteP p) {
    int lane = threadIdx.x & 63, gw = (blockIdx.x * blockDim.x + threadIdx.x) >> 6, ngw = (gridDim.x * blockDim.x) >> 6;
    for (int r = gw; r < T; r += ngw) {
        const float* src = p.H1 + (size_t)r * D; const float* sh = p.ada + (r / L) * 6144 + 3072; const float* sc = sh + 1024;
        float v[16]; float ss = 0.f;
#pragma unroll
        for (int j = 0; j < 4; ++j) { float4 t = *(const float4*)(src + j * 256 + lane * 4); v[4*j] = t.x; v[4*j+1] = t.y; v[4*j+2] = t.z; v[4*j+3] = t.w; ss += t.x*t.x + t.y*t.y + t.z*t.z + t.w*t.w; }
        for (int o = 1; o < 64; o <<= 1) ss += __shfl_xor(ss, o);
        float rstd = rsqrtf(ss * (1.f / D) + EPS);
        float lg[36];
#pragma unroll
        for (int i = 0; i < 36; ++i) lg[i] = 0.f;
#pragma unroll
        for (int j = 0; j < 4; ++j)
#pragma unroll
            for (int i = 0; i < 4; ++i) { int c = j * 256 + lane * 4 + i; float y = v[4*j+i] * rstd * p.gnorm[c]; y = y * (1.f + sc[c]) + sh[c]; p.H2[(size_t)r * D + c] = f2bf(y);
#pragma unroll
                for (int g = 0; g < 4; ++g) lg[g] += y * p.wrg[c * 4 + g];
#pragma unroll
                for (int e = 0; e < 32; ++e) lg[4 + e] += y * p.wre[c * 32 + e]; }
#pragma unroll
        for (int i = 0; i < 36; ++i) { float s = lg[i]; for (int o = 1; o < 64; o <<= 1) s += __shfl_xor(s, o); lg[i] = s; }
        float gl[4];
#pragma unroll
        for (int g = 0; g < 4; ++g) gl[g] = lg[g] + p.brg[g];
        int gs = 0; float gmax = gl[0];
#pragma unroll
        for (int g = 1; g < 4; ++g) if (gl[g] > gmax) { gmax = gl[g]; gs = g; }
        float den = 0.f;
#pragma unroll
        for (int g = 0; g < 4; ++g) den += expf(gl[g] - gmax);
        const float gwt = 1.f / den;
        float el[8];
#pragma unroll
        for (int e = 0; e < 8; ++e) { float t0 = lg[4 + e], t1 = lg[12 + e], t2 = lg[20 + e], t3 = lg[28 + e]; el[e] = (gs == 0 ? t0 : gs == 1 ? t1 : gs == 2 ? t2 : t3) + p.bre[gs * 8 + e]; }
        int i0 = 0; float v0 = el[0];
#pragma unroll
        for (int e = 1; e < 8; ++e) if (el[e] > v0) { v0 = el[e]; i0 = e; }
        int i1 = -1; float v1 = -3.0e38f;
#pragma unroll
        for (int e = 0; e < 8; ++e) if (e != i0 && el[e] > v1) { v1 = el[e]; i1 = e; }
        if (lane == 0) {
            float w0 = 1.f / (1.f + expf(v1 - v0)), w1 = 1.f - w0;
            int e0 = gs * 8 + i0, e1 = gs * 8 + i1;
            p.route[r] = make_int4(e0, e1, 0, 0); p.rw[r] = make_float2(w0 * gwt, w1 * gwt);
            atomicAdd(&p.cnt[e0], 1u); atomicAdd(&p.cnt[e1], 1u);
        }
    }
}
constexpr int MB = 8;
__global__ void k_dispatch(int4* route, const unsigned* cnt, unsigned* cur, int* sorted) {
    __shared__ unsigned off[33];
    if (threadIdx.x == 0) { unsigned o = 0; for (int e = 0; e < 32; ++e) { off[e] = o; o += (cnt[e] + MB - 1) / MB * MB; } off[32] = o; }
    __syncthreads();
    int r = blockIdx.x * blockDim.x + threadIdx.x; if (r >= T) return;
    int4 rt = route[r];
    unsigned s0 = off[rt.x] + atomicAdd(&cur[rt.x], 1u), s1 = off[rt.y] + atomicAdd(&cur[rt.y], 1u);
    sorted[s0] = r; sorted[s1] = r; rt.z = (int)s0; rt.w = (int)s1; route[r] = rt;
}
__global__ __launch_bounds__(512) void k_expert_naive(const bf16* H2, const int* sorted, const unsigned* cnt, const float* wg, const float* wu, const float* wd, float* YS) {
    __shared__ float xs[MB][1024]; __shared__ float hs[MB][256]; __shared__ unsigned off[33]; __shared__ int toks[MB];
    const int t = threadIdx.x;
    if (t == 0) { unsigned o = 0; for (int e = 0; e < 32; ++e) { off[e] = o; o += (cnt[e] + MB - 1) / MB * MB; } off[32] = o; }
    __syncthreads();
    const unsigned s0 = blockIdx.x * MB; if (s0 >= off[32]) return;
    int e = 0; while (off[e + 1] <= s0) ++e;
    const unsigned nreal = cnt[e] - (s0 - off[e]) > (unsigned)MB ? (unsigned)MB : cnt[e] - (s0 - off[e]);
    if (t < MB) toks[t] = t < (int)nreal ? sorted[s0 + t] : -1;
    __syncthreads();
    for (int i = t; i < MB * 1024; i += 512) { int m = i >> 10, c = i & 1023; xs[m][c] = toks[m] >= 0 ? bf2f(H2[(size_t)toks[m] * D + c]) : 0.f; }
    __syncthreads();
    { const int j = t & 255, hm = t >> 8;
      float ag[4], au[4]; for (int i = 0; i < 4; ++i) { ag[i] = 0.f; au[i] = 0.f; }
      const float* pg = wg + (size_t)e * 1024 * 256 + j; const float* pu = wu + (size_t)e * 1024 * 256 + j;
      for (int k = 0; k < 1024; ++k) { const float g = pg[(size_t)k * 256], u = pu[(size_t)k * 256];
          for (int i = 0; i < 4; ++i) { const float x = xs[hm * 4 + i][k]; ag[i] += x * g; au[i] += x * u; } }
      for (int i = 0; i < 4; ++i) hs[hm * 4 + i][j] = ag[i] / (1.f + expf(-ag[i])) * au[i]; }
    __syncthreads();
    { float acc[MB][2]; for (int m = 0; m < MB; ++m) { acc[m][0] = 0.f; acc[m][1] = 0.f; }
      const float* pd = wd + (size_t)e * 256 * 1024;
      for (int j = 0; j < 256; ++j) { const float d0 = pd[(size_t)j * 1024 + t], d1 = pd[(size_t)j * 1024 + 512 + t];
          for (int m = 0; m < MB; ++m) { const float hv = hs[m][j]; acc[m][0] += hv * d0; acc[m][1] += hv * d1; } }
      for (int m = 0; m < MB; ++m) { YS[(size_t)(s0 + m) * 1024 + t] = acc[m][0]; YS[(size_t)(s0 + m) * 1024 + 512 + t] = acc[m][1]; } }
}
__global__ __launch_bounds__(256) void k_final(const float* H1, const float* YS, const int4* route, const float2* rw, const float* ada, const float* gfin, float* out) {
    int lane = threadIdx.x & 63, gw = (blockIdx.x * blockDim.x + threadIdx.x) >> 6, ngw = (gridDim.x * blockDim.x) >> 6;
    for (int r = gw; r < T; r += ngw) {
        const int4 rt = route[r]; const float2 w = rw[r]; const float* g2 = ada + (r / L) * 6144 + 5120;
        float v[16]; float ss = 0.f;
        for (int j = 0; j < 4; ++j) for (int i = 0; i < 4; ++i) { int c = j * 256 + lane * 4 + i;
            float m = w.x * YS[(size_t)rt.z * 1024 + c] + w.y * YS[(size_t)rt.w * 1024 + c];
            float hv = H1[(size_t)r * D + c] + g2[c] * m; v[4*j+i] = hv; ss += hv * hv; }
        for (int o = 1; o < 64; o <<= 1) ss += __shfl_xor(ss, o);
        float rstd = rsqrtf(ss * (1.f / D) + EPS);
        for (int j = 0; j < 4; ++j) for (int i = 0; i < 4; ++i) { int c = j * 256 + lane * 4 + i; out[(size_t)r * D + c] = v[4*j+i] * rstd * gfin[c]; }
    }
}

extern "C" void kernel_launch(void* const* d_in, const int* in_sizes, int n_in, void* d_out, int out_size, void* d_ws, size_t ws_size, hipStream_t stream) {
    const float* x = (const float*)d_in[0]; const float* c = (const float*)d_in[1]; const float* ctx = (const float*)d_in[2]; const float* cctx = (const float*)d_in[3];
    const float* w_ada = (const float*)d_in[4]; const float* b_ada = (const float*)d_in[5]; const float* norm_mix = (const float*)d_in[6]; const float* norm_ffn = (const float*)d_in[7];
    const float* w_in = (const float*)d_in[8]; const float* lrw = (const float*)d_in[9]; const float* lrb = (const float*)d_in[10]; const float* gla_norm = (const float*)d_in[11];
    const float* wbg = (const float*)d_in[12]; const float* wbr = (const float*)d_in[13]; const float* w_out = (const float*)d_in[14];
    const float* wrg = (const float*)d_in[15]; const float* brg = (const float*)d_in[16]; const float* wre = (const float*)d_in[17]; const float* bre = (const float*)d_in[18];
    const float* weg = (const float*)d_in[19]; const float* weu = (const float*)d_in[20]; const float* wed = (const float*)d_in[21]; const float* norm_final = (const float*)d_in[22];
    if (ws_size < WS_END) { fprintf(stderr, "ws too small %zu\n", ws_size); return; }
    unsigned char* ws = (unsigned char*)d_ws;
    unsigned* ctl = (unsigned*)(ws + WS_CTL); float* ada = (float*)(ws + WS_ADA); float2* rope = (float2*)(ws + WS_ROPE); float* LR = (float*)(ws + WS_LR);
    int4* route = (int4*)(ws + WS_ROUTE); float2* rw = (float2*)(ws + WS_ROUTE + 512 * 1024); int* sorted = (int*)(ws + WS_SORT);
    bf16* HL = (bf16*)(ws + WS_HL); bf16* GQ = (bf16*)(ws + WS_GQ); bf16* GK = (bf16*)(ws + WS_GK); bf16* RQ = (bf16*)(ws + WS_RQ); bf16* RK = (bf16*)(ws + WS_RK);
    bf16* GV = (bf16*)(ws + WS_GV); bf16* RV = (bf16*)(ws + WS_RV); bf16* GG = (bf16*)(ws + WS_GG); bf16* RG = (bf16*)(ws + WS_RG);
    float* out = (float*)d_out; bf16* OF = (bf16*)d_out;
    hipMemsetAsync(ws + WS_CTL, 0, 1 * MiB, stream);
    k_ada<<<72, 256, 0, stream>>>(c, cctx, w_ada, b_ada, ada);
    k_rope_tab<<<16, 256, 0, stream>>>(rope);
    k_norm_mod<<<1024, 256, 0, stream>>>(x, ctx, norm_mix, ada, HL);
    { EpiProj e{GQ, GK, GV, GG, RQ, RK, RV, RG, LR}; k_gemm_naive<EpiProj><<<dim3((6176 + 127) / 128, TT / 128), 256, 0, stream>>>(HL, 1024, w_in, INW, TT, 6176, 1024, e); }
    k_rope<<<(T * 256) / 256, 256, 0, stream>>>(RQ, RK, rope);
    ScanP sp{GQ, GK, GV, RQ, RK, RV, GG, RG, LR, lrw, lrb, gla_norm, OF};
    k_scan_naive<0><<<16, 512, 0, stream>>>(sp);
    k_scan_naive<1><<<16, 512, 0, stream>>>(sp);
    bf16* Y = GV; bf16* S2 = RV;
    { EpiSig e{Y}; k_gemm_naive<EpiSig><<<dim3(8, T / 128), 256, 0, stream>>>(HL, 1024, w_in + 6176, INW, T, 1024, 1024, e); }
    { EpiGate1 e{Y}; k_gemm_naive<EpiGate1><<<dim3(8, T / 128), 256, 0, stream>>>(GG, 1024, wbg, 1024, T, 1024, 1024, e); }
    { EpiSig e{S2}; k_gemm_naive<EpiSig><<<dim3(8, T / 128), 256, 0, stream>>>(HL, 1024, w_in + 7200, INW, T, 1024, 1024, e); }
    { EpiGate2 e{Y, S2}; k_gemm_naive<EpiGate2><<<dim3(8, T / 128), 256, 0, stream>>>(RG, 1024, wbr, 1024, T, 1024, 1024, e); }
    float* H1 = (float*)(ws + WS_GQ);
    { EpiOut e{x, ada, H1}; k_gemm_naive<EpiOut><<<dim3(8, T / 128), 256, 0, stream>>>(Y, 1024, w_out, 1024, T, 1024, 1024, e); }
    bf16* H2 = HL;
    RouteP rp{H1, norm_ffn, ada, wrg, brg, wre, bre, H2, route, rw, ctl + CW_CNT};
    k_norm_route<<<1024, 256, 0, stream>>>(rp);
    k_dispatch<<<T / 256, 256, 0, stream>>>(route, ctl + CW_CNT, ctl + CW_CUR, sorted);
    float* YS = (float*)(ws + WS_GV);
    k_expert_naive<<<(2 * T) / MB + 32, 512, 0, stream>>>(H2, sorted, ctl + CW_CNT, weg, weu, wed, YS);
    k_final<<<1024, 256, 0, stream>>>(H1, YS, route, rw, ada, norm_final, out);
}
```

```cpp
#include <hip/hip_runtime.h>
#include <stdint.h>
#include <stdio.h>

typedef unsigned short bf16;
__device__ __forceinline__ float bf2f(bf16 v) { return __uint_as_float(((unsigned)v) << 16); }
__device__ __forceinline__ bf16 f2bf(float f) { unsigned u = __float_as_uint(f); return (bf16)((u + 0x7fffu + ((u >> 16) & 1u)) >> 16); }

constexpr int D = 1024, NB = 2, L = 8192, T = NB * L, CTX = 256, TC = NB * CTX, TT = T + TC;
constexpr int INW = 8224;
constexpr float EPS = 1e-6f;
constexpr size_t MiB = 1u << 20;
constexpr int NTHR = 512;
constexpr size_t WS_CTL = 0;
constexpr size_t WS_ADA = 1 * MiB;
constexpr size_t WS_ROPE = 1 * MiB + 256 * 1024;
constexpr size_t WS_LR = 2 * MiB;
constexpr size_t WS_ROUTE = 5 * MiB;
constexpr size_t WS_SORT = 6 * MiB;
constexpr size_t WS_HL = 8 * MiB;
constexpr size_t WS_GQ = 42 * MiB;
constexpr size_t WS_GK = 58 * MiB;
constexpr size_t WS_RQ = 75 * MiB;
constexpr size_t WS_RK = 91 * MiB;
constexpr size_t WS_GV = 108 * MiB;
constexpr size_t WS_RV = 141 * MiB;
constexpr size_t WS_GG = 174 * MiB;
constexpr size_t WS_RG = 206 * MiB;
constexpr size_t WS_END = 238 * MiB;
constexpr int CW_CNT = 1024;
constexpr int CW_CUR = 1024 + 64;
constexpr int CW_BAR = 4096;
constexpr int LDS_BYTES = 147456;
constexpr int LDS_MISC = LDS_BYTES - 256;

#define XB_TMO      128
#define XB_XCNT(j)  (256  + 64 * (j))
#define XB_XSUB(j)  (1280 + 64 * (j))
#define XB_XGEN(j)  (2304 + 64 * (j))
#define XB_TOP      3328
#define XB_TOPGEN   3392
#define XCD_BAR_WORDS 3456
#define XB_SPIN_CAP (1u << 18)
#define LAS __attribute__((address_space(3)))

__device__ __forceinline__ unsigned xb_ld(unsigned* p)              { return __hip_atomic_load(p, __ATOMIC_RELAXED, __HIP_MEMORY_SCOPE_AGENT); }
__device__ __forceinline__ unsigned xb_add(unsigned* p, unsigned v) { return __hip_atomic_fetch_add(p, v, __ATOMIC_RELAXED, __HIP_MEMORY_SCOPE_AGENT); }
__device__ __forceinline__ unsigned xb_xcc_id() { return (unsigned)__builtin_amdgcn_s_getreg((3 << 11) | 20) & 0xFu; }
#define XB_SPIN(cond, bar) do { unsigned _sp = 0; while (cond) { __builtin_amdgcn_s_sleep(1); \
    if ((++_sp & 255u) == 0u) { if (xb_ld(&(bar)[XB_TMO])) break; if (_sp > XB_SPIN_CAP) { atomicAdd(&(bar)[XB_TMO], 1u); break; } } } } while (0)

struct XcdBarrier {
    unsigned* bar; unsigned x;
    volatile LAS unsigned* st;
};

__device__ __forceinline__ XcdBarrier xcd_barrier_post(unsigned* bar, volatile LAS unsigned* st) {
    XcdBarrier b; b.bar = bar; b.x = xb_xcc_id(); b.st = st;
    if (threadIdx.x == 0) (void)xb_add(&bar[XB_XCNT(b.x)], 1u);
    return b;
}
__device__ __forceinline__ void xcd_barrier_complete(unsigned* bar, unsigned x, unsigned& nloc, unsigned& nx) {
    const unsigned G = gridDim.x * gridDim.y * gridDim.z;
    unsigned sum, cnt, mine, sp = 0u;
    for (;;) {
        sum = 0u; cnt = 0u; mine = 0u;
#pragma unroll
        for (unsigned j = 0; j < 16; ++j) { const unsigned c = xb_ld(&bar[XB_XCNT(j)]); sum += c; cnt += (c > 0u) ? 1u : 0u; mine = (j == x) ? c : mine; }
        if (sum == G) break;
        __builtin_amdgcn_s_sleep(1);
        if ((++sp & 255u) == 0u) { if (xb_ld(&bar[XB_TMO])) break; if (sp > XB_SPIN_CAP) { atomicAdd(&bar[XB_TMO], 1u); break; } }
    }
    nloc = mine > 0u ? mine : 1u; nx = cnt > 0u ? cnt : 1u;
}

__device__ __forceinline__ void xcd_barrier(const XcdBarrier& b) {
    asm volatile("s_waitcnt vmcnt(0)" ::: "memory");
    __syncthreads();
    if (threadIdx.x == 0) {
        unsigned* bar = b.bar;
        __builtin_amdgcn_s_waitcnt(0);
        unsigned nloc = b.st[0], nx = b.st[1];
        if (nloc == 0u) { xcd_barrier_complete(bar, b.x, nloc, nx); b.st[0] = nloc; b.st[1] = nx; }
        const unsigned old = xb_add(&bar[XB_XSUB(b.x)], 1u);
        const unsigned gen = old / nloc;
        if (old + 1u == (gen + 1u) * nloc) {
            __builtin_amdgcn_fence(__ATOMIC_RELEASE, "agent");
            asm volatile("s_waitcnt vmcnt(0)" ::: "memory");
            const unsigned og = xb_add(&bar[XB_TOP], 1u);
            const unsigned tg = og / nx;
            if (og + 1u == (tg + 1u) * nx) xb_add(&bar[XB_TOPGEN], 1u);
            else XB_SPIN(xb_ld(&bar[XB_TOPGEN]) == tg, bar);
            __builtin_amdgcn_fence(__ATOMIC_ACQUIRE, "agent");
            xb_add(&bar[XB_XGEN(b.x)], 1u);
            asm volatile("s_waitcnt vmcnt(0)" ::: "memory");
        } else {
            XB_SPIN(xb_ld(&bar[XB_XGEN(b.x)]) == gen, bar);
            __builtin_amdgcn_fence(__ATOMIC_ACQUIRE, "agent");
            asm volatile("s_waitcnt vmcnt(0)" ::: "memory");
        }
    }
    __syncthreads();
}
#define LDSF(off) ((LAS float*)(lds + (off)))
__device__ __forceinline__ float silu_f(float x) { return x / (1.f + expf(-x)); }

__device__ __forceinline__ void p_ada(LAS unsigned char* lds, const float* c, const float* cctx, const float* w_ada, const float* b_ada, float* ada, float2* rope) {
    const int tid = threadIdx.x;
    LAS float* sil = LDSF(0);
    LAS float* red = LDSF(12288);
    for (int i = tid; i < 3072; i += NTHR) { const int r = i >> 10, k = i & 1023; const float x = r < 2 ? c[r * 1024 + k] : cctx[k]; sil[i] = silu_f(x); }
    __syncthreads();
    const int cj = tid & 31, kq = tid >> 5;
    for (int cb = blockIdx.x; cb < 256; cb += gridDim.x) {
        float a0 = 0.f, a1 = 0.f, a2 = 0.f;
        if (cj < 24) { const float* wp = w_ada + (size_t)(kq * 64) * 6144 + cb * 24 + cj;
#pragma unroll 8
            for (int k = 0; k < 64; ++k) { const float w = wp[(size_t)k * 6144]; a0 += sil[kq * 64 + k] * w; a1 += sil[1024 + kq * 64 + k] * w; a2 += sil[2048 + kq * 64 + k] * w; } }
        red[(kq * 3 + 0) * 32 + cj] = a0; red[(kq * 3 + 1) * 32 + cj] = a1; red[(kq * 3 + 2) * 32 + cj] = a2;
        __syncthreads();
        if (tid < 96) { const int r = tid >> 5, j = tid & 31; if (j < 24) { float s = 0.f; for (int q = 0; q < 16; ++q) s += red[(q * 3 + r) * 32 + j]; const int n = cb * 24 + j; ada[r * 6144 + n] = s + b_ada[n]; } }
        __syncthreads();
    }
    for (int idx = blockIdx.x * NTHR + tid; idx < 128 * 32; idx += gridDim.x * NTHR) {
        const int p = idx / 32, j = idx % 32; const float inv = powf(10000.f, -(float)j / 32.f); const float ang = (float)p * inv;
        rope[idx] = make_float2(cosf(ang), sinf(ang)); }
}
__device__ __forceinline__ void p_norm_mod(const float* x, const float* ctx, const float* gnorm, const float* ada, bf16* hl, int row_lo, int row_hi) {
    const int lane = threadIdx.x & 63, gw = blockIdx.x * (NTHR / 64) + (threadIdx.x >> 6), ngw = gridDim.x * (NTHR / 64);
    for (int r = row_lo + gw; r < row_hi; r += ngw) {
        const float* src = r < T ? x + (size_t)r * D : ctx + (size_t)(r - T) * D;
        const int ar = r < T ? r / L : 2;
        const float* sh = ada + ar * 6144; const float* sc = sh + 1024;
        float4 v[4]; float ss = 0.f;
#pragma unroll
        for (int j = 0; j < 4; ++j) { v[j] = *(const float4*)(src + j * 256 + lane * 4); ss += v[j].x * v[j].x + v[j].y * v[j].y + v[j].z * v[j].z + v[j].w * v[j].w; }
#pragma unroll
        for (int o = 1; o < 64; o <<= 1) ss += __shfl_xor(ss, o);
        const float rstd = rsqrtf(ss * (1.f / D) + EPS);
#pragma unroll
        for (int j = 0; j < 4; ++j) { const int c = j * 256 + lane * 4;
            const float4 g = *(const float4*)(gnorm + c), s1 = *(const float4*)(sc + c), s0 = *(const float4*)(sh + c);
            const float y0 = v[j].x * rstd * g.x * (1.f + s1.x) + s0.x, y1 = v[j].y * rstd * g.y * (1.f + s1.y) + s0.y, y2 = v[j].z * rstd * g.z * (1.f + s1.z) + s0.z, y3 = v[j].w * rstd * g.w * (1.f + s1.w) + s0.w;
            uint2 o2; o2.x = (unsigned)f2bf(y0) | ((unsigned)f2bf(y1) << 16); o2.y = (unsigned)f2bf(y2) | ((unsigned)f2bf(y3) << 16);
            *(uint2*)(hl + (size_t)r * D + c) = o2; }
    }
}
template <class Epi> __device__ __forceinline__ void p_gemm_naive(LAS unsigned char* lds, const bf16* A, int lda, const float* W, int ldw, int M, int N, int K, const Epi& epi) {
    LAS float* As = LDSF(0);
    LAS float* Ws = LDSF(16 * 132 * 4);
    const int tid = threadIdx.x, tx = tid & 31, ty = tid >> 5;
    const int nbn = (N + 127) / 128, nblk = nbn * (M / 128);
    for (int vb = blockIdx.x; vb < nblk; vb += gridDim.x) {
        const int bm = (vb / nbn) * 128, bn = (vb % nbn) * 128;
        float acc[8][4];
#pragma unroll
        for (int i = 0; i < 8; ++i)
#pragma unroll
            for (int j = 0; j < 4; ++j) acc[i][j] = 0.f;
        for (int k0 = 0; k0 < K; k0 += 16) {
            if (tid < 256) { const int r = tid >> 1, kk = (tid & 1) * 8; const bf16* ap = A + (size_t)(bm + r) * lda + k0 + kk;
                const uint4 raw = *(const uint4*)ap; const unsigned w[4] = {raw.x, raw.y, raw.z, raw.w};
#pragma unroll
                for (int i = 0; i < 4; ++i) { As[(kk + 2 * i) * 132 + r] = __uint_as_float(w[i] << 16); As[(kk + 2 * i + 1) * 132 + r] = __uint_as_float(w[i] & 0xffff0000u); } }
            { const int kk = tid >> 5, n = (tid & 31) * 4; const float* wp = W + (size_t)(k0 + kk) * ldw + bn + n;
#pragma unroll
              for (int i = 0; i < 4; ++i) Ws[kk * 132 + n + i] = (bn + n + i < N) ? wp[i] : 0.f; }
            __syncthreads();
#pragma unroll
            for (int kk = 0; kk < 16; ++kk) {
                float a[8], w[4];
#pragma unroll
                for (int i = 0; i < 8; ++i) a[i] = As[kk * 132 + ty * 8 + i];
#pragma unroll
                for (int j = 0; j < 4; ++j) w[j] = Ws[kk * 132 + tx * 4 + j];
#pragma unroll
                for (int i = 0; i < 8; ++i)
#pragma unroll
                    for (int j = 0; j < 4; ++j) acc[i][j] += a[i] * w[j];
            }
            __syncthreads();
        }
#pragma unroll
        for (int i = 0; i < 8; ++i)
#pragma unroll
            for (int j = 0; j < 4; ++j) { const int r = bm + ty * 8 + i, c = bn + tx * 4 + j; if (c < N) epi(r, c, acc[i][j]); }
    }
}
struct EpiProj {
    bf16 *GQ, *GK, *GV, *GG, *RQ, *RK, *RV, *RG; float* LR;
    __device__ __forceinline__ void operator()(int r, int c, float v) const {
        const float s = 0.08838834764831845f;
        if (c < 512) { if (r < T) GQ[(size_t)r * 512 + c] = f2bf(v * s); }
        else if (c < 1024) GK[(size_t)r * 512 + c - 512] = f2bf(v);
        else if (c < 2048) GV[(size_t)r * 1024 + c - 1024] = f2bf(v);
        else if (c < 3072) { if (r < T) GG[(size_t)r * 1024 + c - 2048] = f2bf(v); }
        else if (c < 3104) LR[(size_t)r * 32 + c - 3072] = v;
        else if (c < 3616) { if (r < T) RQ[(size_t)r * 512 + c - 3104] = f2bf(v); }
        else if (c < 4128) RK[(size_t)r * 512 + c - 3616] = f2bf(v * s);
        else if (c < 5152) RV[(size_t)r * 1024 + c - 4128] = f2bf(v);
        else { if (r < T) RG[(size_t)r * 1024 + c - 5152] = f2bf(v); }
    }
};
struct EpiSig { bf16* S; __device__ __forceinline__ void operator()(int r, int c, float v) const { S[(size_t)r * 1024 + c] = f2bf(1.f / (1.f + expf(-v))); } };
struct EpiGate1 { bf16* Y; __device__ __forceinline__ void operator()(int r, int c, float v) const { const size_t i = (size_t)r * 1024 + c; Y[i] = f2bf(bf2f(Y[i]) * v); } };
struct EpiGate2 { bf16* Y; const bf16* S2; __device__ __forceinline__ void operator()(int r, int c, float v) const { const size_t i = (size_t)r * 1024 + c; Y[i] = f2bf(bf2f(Y[i]) + bf2f(S2[i]) * v); } };
struct EpiOut { const float* x; const float* ada; float* H1; __device__ __forceinline__ void operator()(int r, int c, float v) const { const size_t i = (size_t)r * 1024 + c; H1[i] = x[i] + ada[(r / L) * 6144 + 2048 + c] * v; } };

__device__ __forceinline__ void p_rope(bf16* RQ, bf16* RK, const float2* tab) {
    for (size_t idx = (size_t)blockIdx.x * NTHR + threadIdx.x; idx < (size_t)T * 256; idx += (size_t)gridDim.x * NTHR) {
        const int j = idx & 31, half = (idx >> 5) & 1, h = (idx >> 6) & 3; const int r = (int)(idx >> 8);
        const int l = r % L; const int pos = half == 0 ? l / 64 : l % 64;
        const float2 cs = tab[pos * 32 + j];
        const size_t o = (size_t)r * 512 + h * 128 + half * 64 + j;
        { const float u1 = bf2f(RQ[o]), u2 = bf2f(RQ[o + 32]); RQ[o] = f2bf(u1 * cs.x - u2 * cs.y); RQ[o + 32] = f2bf(u1 * cs.y + u2 * cs.x); }
        { const float u1 = bf2f(RK[o]), u2 = bf2f(RK[o + 32]); RK[o] = f2bf(u1 * cs.x - u2 * cs.y); RK[o + 32] = f2bf(u1 * cs.y + u2 * cs.x); }
    }
}
struct ScanP { const bf16 *GQ, *GK, *GV, *RQ, *RK, *RV; bf16 *GG, *RG; const float *LR, *lrw, *lrb, *gnorm; bf16* OF; };
template <int DIR> __device__ __forceinline__ void p_scan_naive(LAS unsigned char* lds, const ScanP& p) {
    const int t = threadIdx.x, w = t >> 6, l = t & 63;
    LAS float* sq = LDSF(0); LAS float* sk = LDSF(512); LAS float* sa = LDSF(1024); LAS float* sv = LDSF(1536); LAS float* red = LDSF(2560); LAS float* rs = LDSF(2560 + 8192);
    for (int unit = blockIdx.x; unit < 16; unit += gridDim.x) {
        const int mixer = unit >> 3, b = (unit >> 2) & 1, h = unit & 3;
        const bf16* Q = mixer ? p.RQ : p.GQ; const bf16* K = mixer ? p.RK : p.GK; const bf16* V = mixer ? p.RV : p.GV; bf16* G = mixer ? p.RG : p.GG;
        float S[16][4];
#pragma unroll
        for (int i = 0; i < 16; ++i)
#pragma unroll
            for (int j = 0; j < 4; ++j) S[i][j] = 0.f;
        const float gamma = 1.f - exp2f(-(DIR ? 5.5f : 5.0f) - (float)h);
        for (int step = 0; step < CTX + L; ++step) {
            const bool isctx = step < CTX; const int idx = isctx ? step : step - CTX;
            const int tok = DIR == 0 ? idx : (isctx ? CTX - 1 - idx : L - 1 - idx);
            const size_t rkv = isctx ? (size_t)T + b * CTX + tok : (size_t)b * L + tok;
            const size_t rq = (size_t)b * L + tok;
            if (t < 128) {
                sk[t] = bf2f(K[rkv * 512 + h * 128 + t]);
                sq[t] = isctx ? 0.f : bf2f(Q[rq * 512 + h * 128 + t]);
                if (mixer == 0) {
                    float z = p.lrb[DIR * 512 + h * 128 + t];
                    for (int r = 0; r < 16; ++r) z += p.LR[rkv * 32 + DIR * 16 + r] * p.lrw[(DIR * 16 + r) * 512 + h * 128 + t];
                    const float ls = fminf(z, 0.f) - log1pf(expf(-fabsf(z)));
                    sa[t] = expf(ls * (1.f / 16.f));
                } else sa[t] = gamma;
            } else if (t < 384) sv[t - 128] = bf2f(V[rkv * 1024 + h * 256 + t - 128]);
            __syncthreads();
            float o[4] = {0.f, 0.f, 0.f, 0.f}; const float v[4] = {sv[4 * l], sv[4 * l + 1], sv[4 * l + 2], sv[4 * l + 3]};
#pragma unroll
            for (int i = 0; i < 16; ++i) { const int dk = 16 * w + i; const float a = sa[dk], kk = sk[dk], qq = sq[dk];
#pragma unroll
                for (int j = 0; j < 4; ++j) {
                    if (DIR == 0) { S[i][j] = a * S[i][j] + kk * v[j]; o[j] += qq * S[i][j]; }
                    else { const float sp = a * S[i][j]; o[j] += qq * sp; S[i][j] = sp + kk * v[j]; } } }
            if (!isctx) {
#pragma unroll
                for (int j = 0; j < 4; ++j) red[w * 256 + 4 * l + j] = o[j];
                __syncthreads();
                float ot = 0.f;
                if (t < 256) { for (int i = 0; i < 8; ++i) ot += red[i * 256 + t]; }
                if (DIR == 0) { if (t < 256) p.OF[rq * 2048 + mixer * 1024 + h * 256 + t] = f2bf(ot); }
                else {
                    if (t < 256) ot += bf2f(p.OF[rq * 2048 + mixer * 1024 + h * 256 + t]);
                    float s1 = t < 256 ? ot : 0.f;
#pragma unroll
                    for (int o2 = 1; o2 < 64; o2 <<= 1) s1 += __shfl_xor(s1, o2);
                    if (l == 0) rs[w] = s1; __syncthreads();
                    const float mu = (rs[0] + rs[1] + rs[2] + rs[3]) * (1.f / 256.f); __syncthreads();
                    const float dv = mixer ? ot - mu : ot;
                    float s2 = t < 256 ? dv * dv : 0.f;
#pragma unroll
                    for (int o2 = 1; o2 < 64; o2 <<= 1) s2 += __shfl_xor(s2, o2);
                    if (l == 0) rs[w] = s2; __syncthreads();
                    const float var = (rs[0] + rs[1] + rs[2] + rs[3]) * (1.f / 256.f);
                    if (t < 256) { float y = dv * rsqrtf(var + EPS); if (mixer == 0) y *= p.gnorm[t];
                        const size_t gi = rq * 1024 + h * 256 + t; const float g = bf2f(G[gi]); y *= silu_f(g); G[gi] = f2bf(y); }
                }
            }
            __syncthreads();
        }
    }
}
struct RouteP { const float *H1, *gnorm, *ada, *wrg, *brg, *wre, *bre; bf16* H2; int4* route; float2* rw; unsigned* cnt; };
__device__ __forceinline__ void p_norm_route(const RouteP& p) {
    const int lane = threadIdx.x & 63, gw = blockIdx.x * (NTHR / 64) + (threadIdx.x >> 6), ngw = gridDim.x * (NTHR / 64);
    for (int r = gw; r < T; r += ngw) {
        const float* src = p.H1 + (size_t)r * D; const float* sh = p.ada + (r / L) * 6144 + 3072; const float* sc = sh + 1024;
        float4 v[4]; float ss = 0.f;
#pragma unroll
        for (int j = 0; j < 4; ++j) { v[j] = *(const float4*)(src + j * 256 + lane * 4); ss += v[j].x * v[j].x + v[j].y * v[j].y + v[j].z * v[j].z + v[j].w * v[j].w; }
#pragma unroll
        for (int o = 1; o < 64; o <<= 1) ss += __shfl_xor(ss, o);
        const float rstd = rsqrtf(ss * (1.f / D) + EPS);
        float gl[4] = {0.f, 0.f, 0.f, 0.f};
#pragma unroll
        for (int j = 0; j < 4; ++j) { const int c = j * 256 + lane * 4;
            const float4 g = *(const float4*)(p.gnorm + c), s1 = *(const float4*)(sc + c), s0 = *(const float4*)(sh + c);
            v[j].x = v[j].x * rstd * g.x * (1.f + s1.x) + s0.x; v[j].y = v[j].y * rstd * g.y * (1.f + s1.y) + s0.y; v[j].z = v[j].z * rstd * g.z * (1.f + s1.z) + s0.z; v[j].w = v[j].w * rstd * g.w * (1.f + s1.w) + s0.w;
            uint2 o2; o2.x = (unsigned)f2bf(v[j].x) | ((unsigned)f2bf(v[j].y) << 16); o2.y = (unsigned)f2bf(v[j].z) | ((unsigned)f2bf(v[j].w) << 16);
            *(uint2*)(p.H2 + (size_t)r * D + c) = o2;
            const float yy[4] = {v[j].x, v[j].y, v[j].z, v[j].w};
#pragma unroll
            for (int i = 0; i < 4; ++i) { const float4 wv = *(const float4*)(p.wrg + (size_t)(c + i) * 4); gl[0] += yy[i] * wv.x; gl[1] += yy[i] * wv.y; gl[2] += yy[i] * wv.z; gl[3] += yy[i] * wv.w; } }
#pragma unroll
        for (int g = 0; g < 4; ++g) { float s = gl[g];
#pragma unroll
            for (int o = 1; o < 64; o <<= 1) s += __shfl_xor(s, o); gl[g] = s + p.brg[g]; }
        int gs = 0; float gmax = gl[0];
#pragma unroll
        for (int g = 1; g < 4; ++g) if (gl[g] > gmax) { gmax = gl[g]; gs = g; }
        float den = 0.f;
#pragma unroll
        for (int g = 0; g < 4; ++g) den += expf(gl[g] - gmax);
        const float gwt = 1.f / den;
        float el[8];
#pragma unroll
        for (int e = 0; e < 8; ++e) el[e] = 0.f;
#pragma unroll
        for (int j = 0; j < 4; ++j) { const int c = j * 256 + lane * 4; const float yy[4] = {v[j].x, v[j].y, v[j].z, v[j].w};
#pragma unroll
            for (int i = 0; i < 4; ++i) { const float* wp = p.wre + (size_t)(c + i) * 32 + gs * 8; const float4 w0 = *(const float4*)wp, w1 = *(const float4*)(wp + 4);
                el[0] += yy[i] * w0.x; el[1] += yy[i] * w0.y; el[2] += yy[i] * w0.z; el[3] += yy[i] * w0.w; el[4] += yy[i] * w1.x; el[5] += yy[i] * w1.y; el[6] += yy[i] * w1.z; el[7] += yy[i] * w1.w; } }
#pragma unroll
        for (int e = 0; e < 8; ++e) { float s = el[e];
#pragma unroll
            for (int o = 1; o < 64; o <<= 1) s += __shfl_xor(s, o); el[e] = s + p.bre[gs * 8 + e]; }
        int i0 = 0; float v0 = el[0];
#pragma unroll
        for (int e = 1; e < 8; ++e) if (el[e] > v0) { v0 = el[e]; i0 = e; }
        int i1 = -1; float v1 = -3.0e38f;
#pragma unroll
        for (int e = 0; e < 8; ++e) if (e != i0 && el[e] > v1) { v1 = el[e]; i1 = e; }
        if (lane == 0) {
            const float w0 = 1.f / (1.f + expf(v1 - v0)), w1 = 1.f - w0;
            const int e0 = gs * 8 + i0, e1 = gs * 8 + i1;
            p.route[r] = make_int4(e0, e1, 0, 0); p.rw[r] = make_float2(w0 * gwt, w1 * gwt);
            atomicAdd(&p.cnt[e0], 1u); atomicAdd(&p.cnt[e1], 1u);
        }
    }
}
constexpr int MB = 8;
__device__ __forceinline__ void p_dispatch(LAS unsigned char* lds, int4* route, const unsigned* cnt, unsigned* cur, int* sorted) {
    LAS unsigned* off = (LAS unsigned*)lds;
    if (threadIdx.x == 0) { unsigned o = 0; for (int e = 0; e < 32; ++e) { off[e] = o; o += (cnt[e] + MB - 1) / MB * MB; } off[32] = o; }
    __syncthreads();
    for (int r = blockIdx.x * NTHR + threadIdx.x; r < T; r += gridDim.x * NTHR) {
        int4 rt = route[r];
        const unsigned s0 = off[rt.x] + atomicAdd(&cur[rt.x], 1u), s1 = off[rt.y] + atomicAdd(&cur[rt.y], 1u);
        sorted[s0] = r; sorted[s1] = r; rt.z = (int)s0; rt.w = (int)s1; route[r] = rt;
    }
    __syncthreads();
}
__device__ __forceinline__ void p_expert_naive(LAS unsigned char* lds, const bf16* H2, const int* sorted, const unsigned* cnt, const float* wg, const float* wu, const float* wd, float* YS) {
    LAS float* xs = LDSF(0);
    LAS float* hs = LDSF(MB * 4096);
    LAS unsigned* off = (LAS unsigned*)(lds + MB * 4096 + MB * 1024);
    LAS int* toks = (LAS int*)(lds + MB * 4096 + MB * 1024 + 256);
    const int t = threadIdx.x;
    if (t == 0) { unsigned o = 0; for (int e = 0; e < 32; ++e) { off[e] = o; o += (cnt[e] + MB - 1) / MB * MB; } off[32] = o; }
    __syncthreads();
    const int nblk = (int)(off[32] / MB);
    for (int vb = blockIdx.x; vb < nblk; vb += gridDim.x) {
        const unsigned s0 = vb * MB;
        int e = 0; while (off[e + 1] <= s0) ++e;
        const unsigned rem = cnt[e] - (s0 - off[e]); const unsigned nreal = rem > (unsigned)MB ? (unsigned)MB : rem;
        __syncthreads();
        if (t < MB) toks[t] = t < (int)nreal ? sorted[s0 + t] : -1;
        __syncthreads();
        for (int i = t; i < MB * 1024; i += NTHR) { const int m = i >> 10, c = i & 1023; xs[i] = toks[m] >= 0 ? bf2f(H2[(size_t)toks[m] * D + c]) : 0.f; }
        __syncthreads();
        { const int j = t & 255, hm = t >> 8;
          float ag[4], au[4];
#pragma unroll
          for (int i = 0; i < 4; ++i) { ag[i] = 0.f; au[i] = 0.f; }
          const float* pg = wg + (size_t)e * 1024 * 256 + j; const float* pu = wu + (size_t)e * 1024 * 256 + j;
          for (int k = 0; k < 1024; ++k) { const float g = pg[(size_t)k * 256], u = pu[(size_t)k * 256];
#pragma unroll
              for (int i = 0; i < 4; ++i) { const float x = xs[(hm * 4 + i) * 1024 + k]; ag[i] += x * g; au[i] += x * u; } }
#pragma unroll
          for (int i = 0; i < 4; ++i) hs[(hm * 4 + i) * 256 + j] = silu_f(ag[i]) * au[i]; }
        __syncthreads();
        { float acc[MB][2];
#pragma unroll
          for (int m = 0; m < MB; ++m) { acc[m][0] = 0.f; acc[m][1] = 0.f; }
          const float* pd = wd + (size_t)e * 256 * 1024;
          for (int j = 0; j < 256; ++j) { const float d0 = pd[(size_t)j * 1024 + t], d1 = pd[(size_t)j * 1024 + 512 + t];
#pragma unroll
              for (int m = 0; m < MB; ++m) { const float hv = hs[m * 256 + j]; acc[m][0] += hv * d0; acc[m][1] += hv * d1; } }
#pragma unroll
          for (int m = 0; m < MB; ++m) { YS[(size_t)(s0 + m) * 1024 + t] = acc[m][0]; YS[(size_t)(s0 + m) * 1024 + 512 + t] = acc[m][1]; } }
    }
    __syncthreads();
}
__device__ __forceinline__ void p_final(const float* H1, const float* YS, const int4* route, const float2* rw, const float* ada, const float* gfin, float* out) {
    const int lane = threadIdx.x & 63, gw = blockIdx.x * (NTHR / 64) + (threadIdx.x >> 6), ngw = gridDim.x * (NTHR / 64);
    for (int r = gw; r < T; r += ngw) {
        const int4 rt = route[r]; const float2 w = rw[r]; const float* g2 = ada + (r / L) * 6144 + 5120;
        float4 v[4]; float ss = 0.f;
#pragma unroll
        for (int j = 0; j < 4; ++j) { const int c = j * 256 + lane * 4;
            const float4 y0 = *(const float4*)(YS + (size_t)rt.z * 1024 + c), y1 = *(const float4*)(YS + (size_t)rt.w * 1024 + c), hh = *(const float4*)(H1 + (size_t)r * D + c), g = *(const float4*)(g2 + c);
            v[j].x = hh.x + g.x * (w.x * y0.x + w.y * y1.x); v[j].y = hh.y + g.y * (w.x * y0.y + w.y * y1.y); v[j].z = hh.z + g.z * (w.x * y0.z + w.y * y1.z); v[j].w = hh.w + g.w * (w.x * y0.w + w.y * y1.w);
            ss += v[j].x * v[j].x + v[j].y * v[j].y + v[j].z * v[j].z + v[j].w * v[j].w; }
#pragma unroll
        for (int o = 1; o < 64; o <<= 1) ss += __shfl_xor(ss, o);
        const float rstd = rsqrtf(ss * (1.f / D) + EPS);
#pragma unroll
        for (int j = 0; j < 4; ++j) { const int c = j * 256 + lane * 4; const float4 g = *(const float4*)(gfin + c);
            float4 o4; o4.x = v[j].x * rstd * g.x; o4.y = v[j].y * rstd * g.y; o4.z = v[j].z * rstd * g.z; o4.w = v[j].w * rstd * g.w;
            *(float4*)(out + (size_t)r * D + c) = o4; }
    }
}
#ifndef MK_N_LAUNCHES
#define MK_N_LAUNCHES 1
#endif
constexpr int NPHASE = 12;
struct Args { const float* in[23]; float* out; unsigned char* ws; int ph_lo, ph_hi; };
__global__ void __launch_bounds__(NTHR, 2) mk_fwd(Args a) {
    extern __shared__ __attribute__((aligned(16))) unsigned char lds_raw[];
    LAS unsigned char* lds = (LAS unsigned char*)lds_raw;
    const int tid = threadIdx.x;
    unsigned char* ws = a.ws;
    unsigned* ctl = (unsigned*)(ws + WS_CTL);
    if (tid < 4) ((LAS unsigned*)(lds + LDS_MISC))[tid] = 0u;
    __syncthreads();
    XcdBarrier bar; bar.bar = ctl + CW_BAR; bar.x = 0; bar.st = nullptr;
    if (a.ph_hi - a.ph_lo > 1) bar = xcd_barrier_post(ctl + CW_BAR, (volatile LAS unsigned*)(lds + LDS_MISC));
    const float* x = a.in[0]; const float* c = a.in[1]; const float* ctx = a.in[2]; const float* cctx = a.in[3];
    const float* w_ada = a.in[4]; const float* b_ada = a.in[5]; const float* norm_mix = a.in[6]; const float* norm_ffn = a.in[7];
    const float* w_in = a.in[8]; const float* lrw = a.in[9]; const float* lrb = a.in[10]; const float* gla_norm = a.in[11];
    const float* wbg = a.in[12]; const float* wbr = a.in[13]; const float* w_out = a.in[14];
    const float* wrg = a.in[15]; const float* brg = a.in[16]; const float* wre = a.in[17]; const float* bre = a.in[18];
    const float* weg = a.in[19]; const float* weu = a.in[20]; const float* wed = a.in[21]; const float* norm_final = a.in[22];
    float* ada = (float*)(ws + WS_ADA); float2* rope = (float2*)(ws + WS_ROPE); float* LR = (float*)(ws + WS_LR);
    int4* route = (int4*)(ws + WS_ROUTE); float2* rw = (float2*)(ws + WS_ROUTE + 512 * 1024); int* sorted = (int*)(ws + WS_SORT);
    bf16* HL = (bf16*)(ws + WS_HL); bf16* GQ = (bf16*)(ws + WS_GQ); bf16* GK = (bf16*)(ws + WS_GK); bf16* RQ = (bf16*)(ws + WS_RQ); bf16* RK = (bf16*)(ws + WS_RK);
    bf16* GV = (bf16*)(ws + WS_GV); bf16* RV = (bf16*)(ws + WS_RV); bf16* GG = (bf16*)(ws + WS_GG); bf16* RG = (bf16*)(ws + WS_RG);
    float* out = a.out; bf16* OF = (bf16*)a.out;
    bf16* Y = GV; bf16* S2 = RV; float* H1 = (float*)(ws + WS_GQ); bf16* H2 = HL; float* YS = (float*)(ws + WS_GV);
    const int lo = a.ph_lo, hi = a.ph_hi;
#define IN(k) (lo <= (k) && (k) < hi)
#define SEAM(k) do { if (IN(k) && IN((k) + 1)) xcd_barrier(bar); } while (0)
    if (IN(0)) { p_ada(lds, c, cctx, w_ada, b_ada, ada, rope); } SEAM(0);
    if (IN(1)) { p_norm_mod(x, ctx, norm_mix, ada, HL, 0, TT); } SEAM(1);
    if (IN(2)) { EpiProj e{GQ, GK, GV, GG, RQ, RK, RV, RG, LR}; p_gemm_naive(lds, HL, 1024, w_in, INW, TT, 6176, 1024, e); } SEAM(2);
    if (IN(3)) { p_rope(RQ, RK, rope); } SEAM(3);
    if (IN(4)) { ScanP sp{GQ, GK, GV, RQ, RK, RV, GG, RG, LR, lrw, lrb, gla_norm, OF}; p_scan_naive<0>(lds, sp); } SEAM(4);
    if (IN(5)) { ScanP sp{GQ, GK, GV, RQ, RK, RV, GG, RG, LR, lrw, lrb, gla_norm, OF}; p_scan_naive<1>(lds, sp); } SEAM(5);
    if (IN(6)) {
        { EpiSig e{Y}; p_gemm_naive(lds, HL, 1024, w_in + 6176, INW, T, 1024, 1024, e); }
        { EpiGate1 e{Y}; p_gemm_naive(lds, GG, 1024, wbg, 1024, T, 1024, 1024, e); }
        { EpiSig e{S2}; p_gemm_naive(lds, HL, 1024, w_in + 7200, INW, T, 1024, 1024, e); }
        { EpiGate2 e{Y, S2}; p_gemm_naive(lds, RG, 1024, wbr, 1024, T, 1024, 1024, e); }
    } SEAM(6);
    if (IN(7)) { EpiOut e{x, ada, H1}; p_gemm_naive(lds, Y, 1024, w_out, 1024, T, 1024, 1024, e); } SEAM(7);
    if (IN(8)) { RouteP rp{H1, norm_ffn, ada, wrg, brg, wre, bre, H2, route, rw, ctl + CW_CNT}; p_norm_route(rp); } SEAM(8);
    if (IN(9)) { p_dispatch(lds, route, ctl + CW_CNT, ctl + CW_CUR, sorted); } SEAM(9);
    if (IN(10)) { p_expert_naive(lds, H2, sorted, ctl + CW_CNT, weg, weu, wed, YS); } SEAM(10);
    if (IN(11)) { p_final(H1, YS, route, rw, ada, norm_final, out); }
#undef IN
#undef SEAM
}

extern "C" void kernel_launch(void* const* d_in, const int* in_sizes, int n_in, void* d_out, int out_size, void* d_ws, size_t ws_size, hipStream_t stream) {
    static int grid = 0;
    if (grid == 0) {
        if (n_in != 23 || ws_size < WS_END) { fprintf(stderr, "kernel_launch: unexpected n_in %d or ws %zu\n", n_in, ws_size); grid = -1; return; }
        int dev = 0, cus = 0, per_cu = 0;
        if (hipGetDevice(&dev) != hipSuccess || hipDeviceGetAttribute(&cus, hipDeviceAttributeMultiprocessorCount, dev) != hipSuccess) { grid = -1; return; }
        if (hipFuncSetAttribute((const void*)mk_fwd, hipFuncAttributeMaxDynamicSharedMemorySize, LDS_BYTES) != hipSuccess) { fprintf(stderr, "kernel_launch: hipFuncSetAttribute failed\n"); grid = -1; return; }
        if (hipOccupancyMaxActiveBlocksPerMultiprocessor(&per_cu, (const void*)mk_fwd, NTHR, LDS_BYTES) != hipSuccess || per_cu < 1) { fprintf(stderr, "kernel_launch: occupancy query says %d\n", per_cu); }
        (void)hipGetLastError();
        grid = cus;
    }
    if (grid < 0) return;
    if (hipMemsetAsync((char*)d_ws + WS_CTL, 0, 1 * MiB, stream) != hipSuccess) return;
    Args a{};
    for (int i = 0; i < 23; ++i) a.in[i] = (const float*)d_in[i];
    a.out = (float*)d_out; a.ws = (unsigned char*)d_ws;
#if MK_N_LAUNCHES == 1
    a.ph_lo = 0; a.ph_hi = NPHASE;
    hipLaunchKernelGGL(mk_fwd, dim3(grid), dim3(NTHR), LDS_BYTES, stream, a);
#else
    for (int p = 0; p < NPHASE; ++p) { a.ph_lo = p; a.ph_hi = p + 1; hipLaunchKernelGGL(mk_fwd, dim3(grid), dim3(NTHR), LDS_BYTES, stream, a); }
#endif
}
```

```cpp
#include <hip/hip_runtime.h>
#include <stdint.h>
#include <stdio.h>

typedef unsigned short bf16;
__device__ __forceinline__ float bf2f(bf16 v) { return __uint_as_float(((unsigned)v) << 16); }
__device__ __forceinline__ bf16 f2bf(float f) { unsigned u = __float_as_uint(f); return (bf16)((u + 0x7fffu + ((u >> 16) & 1u)) >> 16); }

constexpr int D = 1024, NB = 2, L = 8192, T = NB * L, CTX = 256, TC = NB * CTX, TT = T + TC;
constexpr int INW = 8224;
constexpr float EPS = 1e-6f;
constexpr size_t MiB = 1u << 20;
constexpr int NTHR = 512;
constexpr size_t WS_CTL = 0;
constexpr size_t WS_ADA = 1 * MiB;
constexpr size_t WS_ROPE = 1 * MiB + 256 * 1024;
constexpr size_t WS_LR = 2 * MiB;
constexpr size_t WS_ROUTE = 5 * MiB;
constexpr size_t WS_SORT = 6 * MiB;
constexpr size_t WS_WINM = 7 * MiB;
constexpr size_t WS_WBG = 11 * MiB, WS_WBR = 13 * MiB, WS_WOUT = 15 * MiB;
constexpr size_t WS_ST = 17 * MiB;
constexpr size_t WS_GQ = 52 * MiB;
constexpr size_t WS_GK = 68 * MiB;
constexpr size_t WS_RQ = 85 * MiB;
constexpr size_t WS_RK = 101 * MiB;
constexpr size_t WS_GV = 118 * MiB;
constexpr size_t WS_RV = 151 * MiB;
constexpr size_t WS_GG = 184 * MiB;
constexpr size_t WS_RG = 216 * MiB;
constexpr size_t WS_END = 248 * MiB;
constexpr size_t WS_EXPW = 52 * MiB;
constexpr size_t WS_Y = 100 * MiB, WS_S2 = 132 * MiB;
constexpr size_t WS_YS = 100 * MiB;
constexpr size_t DO_HL = 16 * MiB;
constexpr int CW_CNT = 1024;
constexpr int CW_CUR = 1024 + 64;
constexpr int CW_BAR = 4096;
constexpr int LDS_BYTES = 147456;
constexpr int LDS_MISC = LDS_BYTES - 256;

#define XB_TMO      128
#define XB_XCNT(j)  (256  + 64 * (j))
#define XB_XSUB(j)  (1280 + 64 * (j))
#define XB_XGEN(j)  (2304 + 64 * (j))
#define XB_TOP      3328
#define XB_TOPGEN   3392
#define XCD_BAR_WORDS 3456
#define XB_SPIN_CAP (1u << 18)
#define LAS __attribute__((address_space(3)))

__device__ __forceinline__ unsigned xb_ld(unsigned* p)              { return __hip_atomic_load(p, __ATOMIC_RELAXED, __HIP_MEMORY_SCOPE_AGENT); }
__device__ __forceinline__ unsigned xb_add(unsigned* p, unsigned v) { return __hip_atomic_fetch_add(p, v, __ATOMIC_RELAXED, __HIP_MEMORY_SCOPE_AGENT); }
__device__ __forceinline__ unsigned xb_xcc_id() { return (unsigned)__builtin_amdgcn_s_getreg((3 << 11) | 20) & 0xFu; }
#define XB_SPIN(cond, bar) do { unsigned _sp = 0; while (cond) { __builtin_amdgcn_s_sleep(1); \
    if ((++_sp & 255u) == 0u) { if (xb_ld(&(bar)[XB_TMO])) break; if (_sp > XB_SPIN_CAP) { atomicAdd(&(bar)[XB_TMO], 1u); break; } } } } while (0)

struct XcdBarrier {
    unsigned* bar; unsigned x;
    volatile LAS unsigned* st;
};

__device__ __forceinline__ XcdBarrier xcd_barrier_post(unsigned* bar, volatile LAS unsigned* st) {
    XcdBarrier b; b.bar = bar; b.x = xb_xcc_id(); b.st = st;
    if (threadIdx.x == 0) (void)xb_add(&bar[XB_XCNT(b.x)], 1u);
    return b;
}
__device__ __forceinline__ void xcd_barrier_complete(unsigned* bar, unsigned x, unsigned& nloc, unsigned& nx) {
    const unsigned G = gridDim.x * gridDim.y * gridDim.z;
    unsigned sum, cnt, mine, sp = 0u;
    for (;;) {
        sum = 0u; cnt = 0u; mine = 0u;
#pragma unroll
        for (unsigned j = 0; j < 16; ++j) { const unsigned c = xb_ld(&bar[XB_XCNT(j)]); sum += c; cnt += (c > 0u) ? 1u : 0u; mine = (j == x) ? c : mine; }
        if (sum == G) break;
        __builtin_amdgcn_s_sleep(1);
        if ((++sp & 255u) == 0u) { if (xb_ld(&bar[XB_TMO])) break; if (sp > XB_SPIN_CAP) { atomicAdd(&bar[XB_TMO], 1u); break; } }
    }
    nloc = mine > 0u ? mine : 1u; nx = cnt > 0u ? cnt : 1u;
}

__device__ __forceinline__ void xcd_barrier(const XcdBarrier& b) {
    asm volatile("s_waitcnt vmcnt(0)" ::: "memory");
    __syncthreads();
    if (threadIdx.x == 0) {
        unsigned* bar = b.bar;
        __builtin_amdgcn_s_waitcnt(0);
        unsigned nloc = b.st[0], nx = b.st[1];
        if (nloc == 0u) { xcd_barrier_complete(bar, b.x, nloc, nx); b.st[0] = nloc; b.st[1] = nx; }
        const unsigned old = xb_add(&bar[XB_XSUB(b.x)], 1u);
        const unsigned gen = old / nloc;
        if (old + 1u == (gen + 1u) * nloc) {
            __builtin_amdgcn_fence(__ATOMIC_RELEASE, "agent");
            asm volatile("s_waitcnt vmcnt(0)" ::: "memory");
            const unsigned og = xb_add(&bar[XB_TOP], 1u);
            const unsigned tg = og / nx;
            if (og + 1u == (tg + 1u) * nx) xb_add(&bar[XB_TOPGEN], 1u);
            else XB_SPIN(xb_ld(&bar[XB_TOPGEN]) == tg, bar);
            __builtin_amdgcn_fence(__ATOMIC_ACQUIRE, "agent");
            xb_add(&bar[XB_XGEN(b.x)], 1u);
            asm volatile("s_waitcnt vmcnt(0)" ::: "memory");
        } else {
            XB_SPIN(xb_ld(&bar[XB_XGEN(b.x)]) == gen, bar);
            __builtin_amdgcn_fence(__ATOMIC_ACQUIRE, "agent");
            asm volatile("s_waitcnt vmcnt(0)" ::: "memory");
        }
    }
    __syncthreads();
}
namespace pg8 {
#define PG8_LAS __attribute__((address_space(3)))
typedef unsigned short bf16_t;
typedef short bf16x8 __attribute__((ext_vector_type(8)));
typedef float f32x4 __attribute__((ext_vector_type(4)));
typedef unsigned u32x4 __attribute__((ext_vector_type(4)));
constexpr int BM = 256, BK = 64, HALF = 128, HTB = HALF * BK * 2  , STAGE_BYTES = 8 * HTB, NXCD = 8, WGM = 8;

__host__ __device__ __forceinline__ int lds_byte(int r, int c) { const int st = (r >> 4) * 2 + (c >> 5), rr = r & 15, cc = c & 31, ob = rr * 64 + cc * 2; return st * 1024 + (ob ^ (((ob >> 9) & 1) << 5)); }
__host__ __device__ __forceinline__ void stage_rc(int b, int& R, int& C) { const int st = b / 1024, sb = b % 1024, swz = sb ^ (((sb >> 9) & 1) << 5); R = (st >> 1) * 16 + swz / 64; C = (st & 1) * 32 + (swz % 64) / 2; }
__host__ __device__ __forceinline__ int perm32(int rho) { const int n = rho >> 4, i = rho & 15; return 8 * (i >> 2) + 4 * n + (i & 3); }

struct Unit { int pm, pn; };
struct Gemm { const bf16_t* A; const bf16_t* Bt; int M, N, K; };

struct StaticOrder {
    int nM, nN, nwg, G, c;
    __host__ __device__ void init(int M, int N, int G_, int c_) { nM = M / BM; nN = N / BM; nwg = nM * nN; G = G_; c = c_; }
    __host__ __device__ bool next(int i, Unit& u) const {
        const long L = (long)i * G + c; if (L >= nwg) return false;
        int wgid = (int)L; { const int q = nwg / NXCD, r = nwg % NXCD, xcd = wgid % NXCD, off = wgid / NXCD; wgid = (xcd < r ? xcd * (q + 1) : r * (q + 1) + (xcd - r) * q) + off; }
        const int nig = WGM * nN, gid = wgid / nig, fm = gid * WGM, gsz = (nM - fm) < WGM ? (nM - fm) : WGM;
        u.pm = fm + ((wgid % nig) % gsz); u.pn = (wgid % nig) / gsz; return true;
    }
    __device__ __forceinline__ void a_ready(const Unit&) const {}
    __device__ __forceinline__ void done(const Unit&) const {}
};

__device__ __forceinline__ unsigned cvt_pk_bf16(float lo, float hi) { unsigned r; asm volatile("v_cvt_pk_bf16_f32 %0, %1, %2" : "=v"(r) : "v"(lo), "v"(hi)); return r; }
template <class Epi, class Sched, bool ALIGN_EPI = false, bool SP2 = false>
__device__ __forceinline__ void gemm_phase(PG8_LAS unsigned char* lds, const Gemm g, const Sched& S, const Epi& E) {
    const int tid = threadIdx.x, wid = __builtin_amdgcn_readfirstlane(tid >> 6), lane = tid & 63, wr = wid >> 2, wc = wid & 3, fr = lane & 15, fq = lane >> 4;
    const int K = g.K, nt = K / BK;
    unsigned voffA[2], voffB[2];
#pragma unroll
    for (int i = 0; i < 2; ++i) { int R, C; stage_rc(tid * 16 + i * 8192, R, C); const int Rb = Epi::PERM ? ((R & ~31) + perm32(R & 31)) : R;
        voffA[i] = (unsigned)(R * K + C) * 2u; voffB[i] = (unsigned)(Rb * K + C) * 2u; }
    const size_t kstep = (size_t)(BK * 2);
    const size_t hstep = (size_t)HALF * K * 2;
    const size_t tstep = 2 * hstep;
    const unsigned ldsw = (unsigned)wid * 1024u;
    const int aoff = lds_byte(wr * 64 + fr, fq * 8), boff = lds_byte(wc * 32 + fr, fq * 8);
#define PG8_SA(b, h) (((b) * 2 + (h)) * HTB)
#define PG8_SB(b, h) ((4 + (b) * 2 + (h)) * HTB)
#define PG8_STAGE(bufoff, gbase, voff) do { _Pragma("unroll") for (int _i = 0; _i < 2; ++_i) \
        __builtin_amdgcn_global_load_lds((const unsigned*)((const char*)(gbase) + (voff)[_i]), (PG8_LAS unsigned*)(lds + (bufoff) + ldsw + _i * 8192), 16, 0, 0); } while (0)
#define PG8_LDA(dst, b, h) do { _Pragma("unroll") for (int m = 0; m < 4; ++m) _Pragma("unroll") for (int k = 0; k < 2; ++k) dst[m][k] = *(const PG8_LAS bf16x8*)(lds + PG8_SA(b, h) + aoff + m * 2048 + k * 1024); } while (0)
#define PG8_LDB(dst, b, h) do { _Pragma("unroll") for (int n = 0; n < 2; ++n) _Pragma("unroll") for (int k = 0; k < 2; ++k) dst[n][k] = *(const PG8_LAS bf16x8*)(lds + PG8_SB(b, h) + boff + n * 2048 + k * 1024); } while (0)
#define PG8_MMA(ai, bj, At, Bt) do { __builtin_amdgcn_s_setprio(1); _Pragma("unroll") for (int m = 0; m < 4; ++m) _Pragma("unroll") for (int n = 0; n < 2; ++n) _Pragma("unroll") for (int k = 0; k < 2; ++k) \
        acc[ai][bj][m][n] = __builtin_amdgcn_mfma_f32_16x16x32_bf16(Bt[n][k], At[m][k], acc[ai][bj][m][n], 0, 0, 0); __builtin_amdgcn_s_setprio(0); } while (0)
#define PG8_WAIT_V(n) asm volatile("s_waitcnt vmcnt(" #n ")" ::: "memory")
#define PG8_WAIT_L(n) asm volatile("s_waitcnt lgkmcnt(" #n ")" ::: "memory")
#define PG8_BAR __builtin_amdgcn_s_barrier()
#define PG8_SCHED __builtin_amdgcn_sched_barrier(0)
    Unit cur, nxt; int ui = 0;
    if (!S.next(0, cur)) return;
    f32x4 acc[2][2][4][2];
#pragma unroll
    for (int a = 0; a < 2; ++a)
#pragma unroll
        for (int b = 0; b < 2; ++b)
#pragma unroll
            for (int m = 0; m < 4; ++m)
#pragma unroll
                for (int n = 0; n < 2; ++n) acc[a][b][m][n] = (f32x4){0.f, 0.f, 0.f, 0.f};
    bf16x8 At[4][2], B0[2][2], B1[2][2];
    const char* cA = (const char*)g.A + (size_t)cur.pm * tstep; const char* cB = (const char*)g.Bt + (size_t)cur.pn * tstep;
    S.a_ready(cur);
    if constexpr (SP2) {
        PG8_STAGE(PG8_SB(0, 0), cB, voffB); PG8_STAGE(PG8_SB(0, 1), cB + hstep, voffB); PG8_STAGE(PG8_SA(0, 0), cA, voffA); PG8_STAGE(PG8_SA(0, 1), cA + hstep, voffA);
        if (wr == 1) PG8_BAR;
        PG8_WAIT_V(2); PG8_BAR;
        PG8_STAGE(PG8_SB(1, 0), cB + kstep, voffB); PG8_STAGE(PG8_SA(1, 0), cA + kstep, voffA); PG8_STAGE(PG8_SB(1, 1), cB + hstep + kstep, voffB);
        PG8_WAIT_V(6); PG8_BAR;
    } else {
        PG8_STAGE(PG8_SB(0, 0), cB, voffB); PG8_STAGE(PG8_SA(0, 0), cA, voffA); PG8_STAGE(PG8_SB(0, 1), cB + hstep, voffB); PG8_STAGE(PG8_SA(0, 1), cA + hstep, voffA);
        if (wr == 1) PG8_BAR;
        PG8_WAIT_V(4); PG8_BAR;
        PG8_STAGE(PG8_SB(1, 0), cB + kstep, voffB); PG8_STAGE(PG8_SA(1, 0), cA + kstep, voffA); PG8_STAGE(PG8_SB(1, 1), cB + hstep + kstep, voffB);
        PG8_WAIT_V(6); PG8_BAR;
    }
    for (;;) {
        const bool has_next = S.next(ui + 1, nxt);
        const char* nA = has_next ? (const char*)g.A + (size_t)nxt.pm * tstep : cA; const char* nB = has_next ? (const char*)g.Bt + (size_t)nxt.pn * tstep : cB;
        for (int t = 0; t < nt; t += 2) {
            const bool last = (t == nt - 2);
            const char* a1 = cA + (size_t)(t + 1) * kstep;
            const char* a2 = last ? nA : cA + (size_t)(t + 2) * kstep; const char* b2 = last ? nB : cB + (size_t)(t + 2) * kstep;
            const char* a3 = a2 + kstep; const char* b3 = b2 + kstep;
            if (last && has_next) S.a_ready(nxt);
            if constexpr (SP2) {
            PG8_LDB(B0, 0, 0); PG8_LDB(B1, 0, 1); PG8_SCHED; PG8_LDA(At, 0, 0); PG8_STAGE(PG8_SA(1, 1), a1 + hstep, voffA);
            PG8_WAIT_V(8); PG8_WAIT_L(0); PG8_BAR; PG8_MMA(0, 0, At, B0); PG8_MMA(0, 1, At, B1); PG8_BAR; PG8_SCHED;
            PG8_LDA(At, 0, 1); PG8_STAGE(PG8_SB(0, 0), b2, voffB); PG8_STAGE(PG8_SB(0, 1), b2 + hstep, voffB); PG8_STAGE(PG8_SA(0, 0), a2, voffA);
            PG8_WAIT_V(8); PG8_WAIT_L(0); PG8_BAR; PG8_MMA(1, 0, At, B0); PG8_MMA(1, 1, At, B1); PG8_BAR; PG8_SCHED;
            PG8_LDB(B0, 1, 0); PG8_LDB(B1, 1, 1); PG8_SCHED; PG8_LDA(At, 1, 0); PG8_STAGE(PG8_SA(0, 1), a2 + hstep, voffA);
            PG8_WAIT_V(8); PG8_WAIT_L(0); PG8_BAR; PG8_MMA(0, 0, At, B0); PG8_MMA(0, 1, At, B1); PG8_BAR; PG8_SCHED;
            PG8_LDA(At, 1, 1); PG8_STAGE(PG8_SB(1, 0), b3, voffB); PG8_STAGE(PG8_SB(1, 1), b3 + hstep, voffB); PG8_STAGE(PG8_SA(1, 0), a3, voffA);
            PG8_WAIT_V(8); PG8_WAIT_L(0); PG8_BAR; PG8_MMA(1, 0, At, B0); PG8_MMA(1, 1, At, B1); PG8_BAR; PG8_SCHED;
            } else {
            PG8_LDB(B0, 0, 0); PG8_SCHED; PG8_LDA(At, 0, 0); PG8_STAGE(PG8_SA(1, 1), a1 + hstep, voffA);
            PG8_WAIT_L(8); PG8_BAR; PG8_WAIT_L(0); PG8_MMA(0, 0, At, B0); PG8_BAR; PG8_SCHED;
            PG8_LDB(B1, 0, 1); PG8_STAGE(PG8_SB(0, 0), b2, voffB);
            PG8_BAR; PG8_WAIT_L(0); PG8_MMA(0, 1, At, B1); PG8_BAR;
            PG8_LDA(At, 0, 1); PG8_STAGE(PG8_SA(0, 0), a2, voffA);
            PG8_BAR; PG8_WAIT_L(0); PG8_MMA(1, 0, At, B0); PG8_BAR; PG8_SCHED;
            PG8_STAGE(PG8_SB(0, 1), b2 + hstep, voffB);
            PG8_WAIT_V(6); PG8_BAR; PG8_MMA(1, 1, At, B1); PG8_BAR;
            PG8_LDB(B0, 1, 0); PG8_SCHED; PG8_LDA(At, 1, 0); PG8_STAGE(PG8_SA(0, 1), a2 + hstep, voffA);
            PG8_WAIT_L(8); PG8_BAR; PG8_WAIT_L(0); PG8_MMA(0, 0, At, B0); PG8_BAR; PG8_SCHED;
            PG8_LDB(B1, 1, 1); PG8_STAGE(PG8_SB(1, 0), b3, voffB);
            PG8_BAR; PG8_WAIT_L(0); PG8_MMA(0, 1, At, B1); PG8_BAR;
            PG8_LDA(At, 1, 1); PG8_STAGE(PG8_SA(1, 0), a3, voffA);
            PG8_BAR; PG8_WAIT_L(0); PG8_MMA(1, 0, At, B0); PG8_BAR; PG8_SCHED;
            PG8_STAGE(PG8_SB(1, 1), b3 + hstep, voffB);
            PG8_WAIT_V(6); PG8_BAR; PG8_MMA(1, 1, At, B1); PG8_BAR;
            }
        }
        if constexpr (ALIGN_EPI) { if (wr == 0) PG8_BAR; }
        if constexpr (!Epi::AFTER_DRAIN) { E(acc, cur, wr, wc, fr, fq); S.done(cur); }
        if (!has_next) break;
#pragma unroll
        for (int a = 0; a < 2; ++a)
#pragma unroll
            for (int b = 0; b < 2; ++b)
#pragma unroll
                for (int m = 0; m < 4; ++m)
#pragma unroll
                    for (int n = 0; n < 2; ++n) acc[a][b][m][n] = (f32x4){0.f, 0.f, 0.f, 0.f};
        cur = nxt; cA = nA; cB = nB; ++ui;
        if constexpr (ALIGN_EPI) { if (wr == 1) PG8_BAR; }
    }
    PG8_WAIT_V(0);
    if constexpr (!ALIGN_EPI) { if (wr == 0) PG8_BAR; }
    PG8_BAR;
    if constexpr (Epi::AFTER_DRAIN) { E.fused(acc, cur, wr, wc, fr, fq, lds, wid, lane); S.done(cur); }
#undef PG8_SA
#undef PG8_SB
#undef PG8_STAGE
#undef PG8_LDA
#undef PG8_LDB
#undef PG8_MMA
#undef PG8_WAIT_V
#undef PG8_WAIT_L
#undef PG8_BAR
#undef PG8_SCHED
}
}
#define LDSF(off) ((LAS float*)(lds + (off)))
__device__ __forceinline__ float silu_f(float x) { return x / (1.f + expf(-x)); }

__device__ __forceinline__ void p_ada(LAS unsigned char* lds, const float* c, const float* cctx, const float* w_ada, const float* b_ada, float* ada, float2* rope) {
    const int tid = threadIdx.x;
    LAS float* sil = LDSF(0);
    LAS float* red = LDSF(12288);
    for (int i = tid; i < 3072; i += NTHR) { const int r = i >> 10, k = i & 1023; const float x = r < 2 ? c[r * 1024 + k] : cctx[k]; sil[i] = silu_f(x); }
    __syncthreads();
    const int cj = tid & 31, kq = tid >> 5;
    for (int cb = blockIdx.x; cb < 256; cb += gridDim.x) {
        float a0 = 0.f, a1 = 0.f, a2 = 0.f;
        if (cj < 24) { const float* wp = w_ada + (size_t)(kq * 64) * 6144 + cb * 24 + cj;
#pragma unroll 8
            for (int k = 0; k < 64; ++k) { const float w = wp[(size_t)k * 6144]; a0 += sil[kq * 64 + k] * w; a1 += sil[1024 + kq * 64 + k] * w; a2 += sil[2048 + kq * 64 + k] * w; } }
        red[(kq * 3 + 0) * 32 + cj] = a0; red[(kq * 3 + 1) * 32 + cj] = a1; red[(kq * 3 + 2) * 32 + cj] = a2;
        __syncthreads();
        if (tid < 96) { const int r = tid >> 5, j = tid & 31; if (j < 24) { float s = 0.f; for (int q = 0; q < 16; ++q) s += red[(q * 3 + r) * 32 + j]; const int n = cb * 24 + j; ada[r * 6144 + n] = s + b_ada[n]; } }
        __syncthreads();
    }
    for (int idx = blockIdx.x * NTHR + tid; idx < 128 * 32; idx += gridDim.x * NTHR) {
        const int p = idx / 32, j = idx % 32; const float inv = powf(10000.f, -(float)j / 32.f); const float ang = (float)p * inv;
        rope[idx] = make_float2(cosf(ang), sinf(ang)); }
}
__device__ __forceinline__ void p_norm_mod(const float* x, const float* ctx, const float* gnorm, const float* ada, bf16* hl, int row_lo, int row_hi) {
    const int lane = threadIdx.x & 63, gw = blockIdx.x * (NTHR / 64) + (threadIdx.x >> 6), ngw = gridDim.x * (NTHR / 64);
    for (int r = row_lo + gw; r < row_hi; r += ngw) {
        const float* src = r < T ? x + (size_t)r * D : ctx + (size_t)(r - T) * D;
        const int ar = r < T ? r / L : 2;
        const float* sh = ada + ar * 6144; const float* sc = sh + 1024;
        float4 v[4]; float ss = 0.f;
#pragma unroll
        for (int j = 0; j < 4; ++j) { v[j] = *(const float4*)(src + j * 256 + lane * 4); ss += v[j].x * v[j].x + v[j].y * v[j].y + v[j].z * v[j].z + v[j].w * v[j].w; }
#pragma unroll
        for (int o = 1; o < 64; o <<= 1) ss += __shfl_xor(ss, o);
        const float rstd = rsqrtf(ss * (1.f / D) + EPS);
#pragma unroll
        for (int j = 0; j < 4; ++j) { const int c = j * 256 + lane * 4;
            const float4 g = *(const float4*)(gnorm + c), s1 = *(const float4*)(sc + c), s0 = *(const float4*)(sh + c);
            const float y0 = v[j].x * rstd * g.x * (1.f + s1.x) + s0.x, y1 = v[j].y * rstd * g.y * (1.f + s1.y) + s0.y, y2 = v[j].z * rstd * g.z * (1.f + s1.z) + s0.z, y3 = v[j].w * rstd * g.w * (1.f + s1.w) + s0.w;
            uint2 o2; o2.x = (unsigned)f2bf(y0) | ((unsigned)f2bf(y1) << 16); o2.y = (unsigned)f2bf(y2) | ((unsigned)f2bf(y3) << 16);
            *(uint2*)(hl + (size_t)r * D + c) = o2; }
    }
}
template <class Epi> __device__ __forceinline__ void p_gemm_naive(LAS unsigned char* lds, const bf16* A, int lda, const float* W, int ldw, int M, int N, int K, const Epi& epi) {
    LAS float* As = LDSF(0);
    LAS float* Ws = LDSF(16 * 132 * 4);
    const int tid = threadIdx.x, tx = tid & 31, ty = tid >> 5;
    const int nbn = (N + 127) / 128, nblk = nbn * (M / 128);
    for (int vb = blockIdx.x; vb < nblk; vb += gridDim.x) {
        const int bm = (vb / nbn) * 128, bn = (vb % nbn) * 128;
        float acc[8][4];
#pragma unroll
        for (int i = 0; i < 8; ++i)
#pragma unroll
            for (int j = 0; j < 4; ++j) acc[i][j] = 0.f;
        for (int k0 = 0; k0 < K; k0 += 16) {
            if (tid < 256) { const int r = tid >> 1, kk = (tid & 1) * 8; const bf16* ap = A + (size_t)(bm + r) * lda + k0 + kk;
                const uint4 raw = *(const uint4*)ap; const unsigned w[4] = {raw.x, raw.y, raw.z, raw.w};
#pragma unroll
                for (int i = 0; i < 4; ++i) { As[(kk + 2 * i) * 132 + r] = __uint_as_float(w[i] << 16); As[(kk + 2 * i + 1) * 132 + r] = __uint_as_float(w[i] & 0xffff0000u); } }
            { const int kk = tid >> 5, n = (tid & 31) * 4; const float* wp = W + (size_t)(k0 + kk) * ldw + bn + n;
#pragma unroll
              for (int i = 0; i < 4; ++i) Ws[kk * 132 + n + i] = (bn + n + i < N) ? wp[i] : 0.f; }
            __syncthreads();
#pragma unroll
            for (int kk = 0; kk < 16; ++kk) {
                float a[8], w[4];
#pragma unroll
                for (int i = 0; i < 8; ++i) a[i] = As[kk * 132 + ty * 8 + i];
#pragma unroll
                for (int j = 0; j < 4; ++j) w[j] = Ws[kk * 132 + tx * 4 + j];
#pragma unroll
                for (int i = 0; i < 8; ++i)
#pragma unroll
                    for (int j = 0; j < 4; ++j) acc[i][j] += a[i] * w[j];
            }
            __syncthreads();
        }
#pragma unroll
        for (int i = 0; i < 8; ++i)
#pragma unroll
            for (int j = 0; j < 4; ++j) { const int r = bm + ty * 8 + i, c = bn + tx * 4 + j; if (c < N) epi(r, c, acc[i][j]); }
    }
}
struct EpiProj {
    bf16 *GQ, *GK, *GV, *GG, *RQ, *RK, *RV, *RG; float* LR;
    __device__ __forceinline__ void operator()(int r, int c, float v) const {
        const float s = 0.08838834764831845f;
        if (c < 512) { if (r < T) GQ[(size_t)r * 512 + c] = f2bf(v * s); }
        else if (c < 1024) GK[(size_t)r * 512 + c - 512] = f2bf(v);
        else if (c < 2048) GV[(size_t)r * 1024 + c - 1024] = f2bf(v);
        else if (c < 3072) { if (r < T) GG[(size_t)r * 1024 + c - 2048] = f2bf(v); }
        else if (c < 3104) LR[(size_t)r * 32 + c - 3072] = v;
        else if (c < 3616) { if (r < T) RQ[(size_t)r * 512 + c - 3104] = f2bf(v); }
        else if (c < 4128) RK[(size_t)r * 512 + c - 3616] = f2bf(v * s);
        else if (c < 5152) RV[(size_t)r * 1024 + c - 4128] = f2bf(v);
        else { if (r < T) RG[(size_t)r * 1024 + c - 5152] = f2bf(v); }
    }
};
struct EpiSig { bf16* S; __device__ __forceinline__ void operator()(int r, int c, float v) const { S[(size_t)r * 1024 + c] = f2bf(1.f / (1.f + expf(-v))); } };
struct EpiGate1 { bf16* Y; __device__ __forceinline__ void operator()(int r, int c, float v) const { const size_t i = (size_t)r * 1024 + c; Y[i] = f2bf(bf2f(Y[i]) * v); } };
struct EpiGate2 { bf16* Y; const bf16* S2; __device__ __forceinline__ void operator()(int r, int c, float v) const { const size_t i = (size_t)r * 1024 + c; Y[i] = f2bf(bf2f(Y[i]) + bf2f(S2[i]) * v); } };
struct EpiOut { const float* x; const float* ada; float* H1; __device__ __forceinline__ void operator()(int r, int c, float v) const { const size_t i = (size_t)r * 1024 + c; H1[i] = x[i] + ada[(r / L) * 6144 + 2048 + c] * v; } };

__device__ __forceinline__ void p_rope(bf16* RQ, bf16* RK, const float2* tab) {
    for (size_t idx = (size_t)blockIdx.x * NTHR + threadIdx.x; idx < (size_t)T * 256; idx += (size_t)gridDim.x * NTHR) {
        const int j = idx & 31, half = (idx >> 5) & 1, h = (idx >> 6) & 3; const int r = (int)(idx >> 8);
        const int l = r % L; const int pos = half == 0 ? l / 64 : l % 64;
        const float2 cs = tab[pos * 32 + j];
        const size_t o = (size_t)r * 512 + h * 128 + half * 64 + j;
        { const float u1 = bf2f(RQ[o]), u2 = bf2f(RQ[o + 32]); RQ[o] = f2bf(u1 * cs.x - u2 * cs.y); RQ[o + 32] = f2bf(u1 * cs.y + u2 * cs.x); }
        { const float u1 = bf2f(RK[o]), u2 = bf2f(RK[o + 32]); RK[o] = f2bf(u1 * cs.x - u2 * cs.y); RK[o + 32] = f2bf(u1 * cs.y + u2 * cs.x); }
    }
}
struct ScanP { const bf16 *GQ, *GK, *GV, *RQ, *RK, *RV; bf16 *GG, *RG; const float *LR, *lrw, *lrb, *gnorm; bf16* OF; };
template <int DIR> __device__ __forceinline__ void p_scan_naive(LAS unsigned char* lds, const ScanP& p) {
    const int t = threadIdx.x, w = t >> 6, l = t & 63;
    LAS float* sq = LDSF(0); LAS float* sk = LDSF(512); LAS float* sa = LDSF(1024); LAS float* sv = LDSF(1536); LAS float* red = LDSF(2560); LAS float* rs = LDSF(2560 + 8192);
    for (int unit = blockIdx.x; unit < 16; unit += gridDim.x) {
        const int mixer = unit >> 3, b = (unit >> 2) & 1, h = unit & 3;
        const bf16* Q = mixer ? p.RQ : p.GQ; const bf16* K = mixer ? p.RK : p.GK; const bf16* V = mixer ? p.RV : p.GV; bf16* G = mixer ? p.RG : p.GG;
        float S[16][4];
#pragma unroll
        for (int i = 0; i < 16; ++i)
#pragma unroll
            for (int j = 0; j < 4; ++j) S[i][j] = 0.f;
        const float gamma = 1.f - exp2f(-(DIR ? 5.5f : 5.0f) - (float)h);
        for (int step = 0; step < CTX + L; ++step) {
            const bool isctx = step < CTX; const int idx = isctx ? step : step - CTX;
            const int tok = DIR == 0 ? idx : (isctx ? CTX - 1 - idx : L - 1 - idx);
            const size_t rkv = isctx ? (size_t)T + b * CTX + tok : (size_t)b * L + tok;
            const size_t rq = (size_t)b * L + tok;
            if (t < 128) {
                sk[t] = bf2f(K[rkv * 512 + h * 128 + t]);
                sq[t] = isctx ? 0.f : bf2f(Q[rq * 512 + h * 128 + t]);
                if (mixer == 0) {
                    float z = p.lrb[DIR * 512 + h * 128 + t];
                    for (int r = 0; r < 16; ++r) z += p.LR[rkv * 32 + DIR * 16 + r] * p.lrw[(DIR * 16 + r) * 512 + h * 128 + t];
                    const float ls = fminf(z, 0.f) - log1pf(expf(-fabsf(z)));
                    sa[t] = expf(ls * (1.f / 16.f));
                } else sa[t] = gamma;
            } else if (t < 384) sv[t - 128] = bf2f(V[rkv * 1024 + h * 256 + t - 128]);
            __syncthreads();
            float o[4] = {0.f, 0.f, 0.f, 0.f}; const float v[4] = {sv[4 * l], sv[4 * l + 1], sv[4 * l + 2], sv[4 * l + 3]};
#pragma unroll
            for (int i = 0; i < 16; ++i) { const int dk = 16 * w + i; const float a = sa[dk], kk = sk[dk], qq = sq[dk];
#pragma unroll
                for (int j = 0; j < 4; ++j) {
                    if (DIR == 0) { S[i][j] = a * S[i][j] + kk * v[j]; o[j] += qq * S[i][j]; }
                    else { const float sp = a * S[i][j]; o[j] += qq * sp; S[i][j] = sp + kk * v[j]; } } }
            if (!isctx) {
#pragma unroll
                for (int j = 0; j < 4; ++j) red[w * 256 + 4 * l + j] = o[j];
                __syncthreads();
                float ot = 0.f;
                if (t < 256) { for (int i = 0; i < 8; ++i) ot += red[i * 256 + t]; }
                if (DIR == 0) { if (t < 256) p.OF[rq * 2048 + mixer * 1024 + h * 256 + t] = f2bf(ot); }
                else {
                    if (t < 256) ot += bf2f(p.OF[rq * 2048 + mixer * 1024 + h * 256 + t]);
                    float s1 = t < 256 ? ot : 0.f;
#pragma unroll
                    for (int o2 = 1; o2 < 64; o2 <<= 1) s1 += __shfl_xor(s1, o2);
                    if (l == 0) rs[w] = s1; __syncthreads();
                    const float mu = (rs[0] + rs[1] + rs[2] + rs[3]) * (1.f / 256.f); __syncthreads();
                    const float dv = mixer ? ot - mu : ot;
                    float s2 = t < 256 ? dv * dv : 0.f;
#pragma unroll
                    for (int o2 = 1; o2 < 64; o2 <<= 1) s2 += __shfl_xor(s2, o2);
                    if (l == 0) rs[w] = s2; __syncthreads();
                    const float var = (rs[0] + rs[1] + rs[2] + rs[3]) * (1.f / 256.f);
                    if (t < 256) { float y = dv * rsqrtf(var + EPS); if (mixer == 0) y *= p.gnorm[t];
                        const size_t gi = rq * 1024 + h * 256 + t; const float g = bf2f(G[gi]); y *= silu_f(g); G[gi] = f2bf(y); }
                }
            }
            __syncthreads();
        }
    }
}
struct RouteP { const float *H1, *gnorm, *ada, *wrg, *brg, *wre, *bre; bf16* H2; int4* route; float2* rw; unsigned* cnt; };
__device__ __forceinline__ void p_norm_route(const RouteP& p) {
    const int lane = threadIdx.x & 63, gw = blockIdx.x * (NTHR / 64) + (threadIdx.x >> 6), ngw = gridDim.x * (NTHR / 64);
    for (int r = gw; r < T; r += ngw) {
        const float* src = p.H1 + (size_t)r * D; const float* sh = p.ada + (r / L) * 6144 + 3072; const float* sc = sh + 1024;
        float4 v[4]; float ss = 0.f;
#pragma unroll
        for (int j = 0; j < 4; ++j) { v[j] = *(const float4*)(src + j * 256 + lane * 4); ss += v[j].x * v[j].x + v[j].y * v[j].y + v[j].z * v[j].z + v[j].w * v[j].w; }
#pragma unroll
        for (int o = 1; o < 64; o <<= 1) ss += __shfl_xor(ss, o);
        const float rstd = rsqrtf(ss * (1.f / D) + EPS);
        float gl[4] = {0.f, 0.f, 0.f, 0.f};
#pragma unroll
        for (int j = 0; j < 4; ++j) { const int c = j * 256 + lane * 4;
            const float4 g = *(const float4*)(p.gnorm + c), s1 = *(const float4*)(sc + c), s0 = *(const float4*)(sh + c);
            v[j].x = v[j].x * rstd * g.x * (1.f + s1.x) + s0.x; v[j].y = v[j].y * rstd * g.y * (1.f + s1.y) + s0.y; v[j].z = v[j].z * rstd * g.z * (1.f + s1.z) + s0.z; v[j].w = v[j].w * rstd * g.w * (1.f + s1.w) + s0.w;
            uint2 o2; o2.x = (unsigned)f2bf(v[j].x) | ((unsigned)f2bf(v[j].y) << 16); o2.y = (unsigned)f2bf(v[j].z) | ((unsigned)f2bf(v[j].w) << 16);
            *(uint2*)(p.H2 + (size_t)r * D + c) = o2;
            const float yy[4] = {v[j].x, v[j].y, v[j].z, v[j].w};
#pragma unroll
            for (int i = 0; i < 4; ++i) { const float4 wv = *(const float4*)(p.wrg + (size_t)(c + i) * 4); gl[0] += yy[i] * wv.x; gl[1] += yy[i] * wv.y; gl[2] += yy[i] * wv.z; gl[3] += yy[i] * wv.w; } }
#pragma unroll
        for (int g = 0; g < 4; ++g) { float s = gl[g];
#pragma unroll
            for (int o = 1; o < 64; o <<= 1) s += __shfl_xor(s, o); gl[g] = s + p.brg[g]; }
        int gs = 0; float gmax = gl[0];
#pragma unroll
        for (int g = 1; g < 4; ++g) if (gl[g] > gmax) { gmax = gl[g]; gs = g; }
        float den = 0.f;
#pragma unroll
        for (int g = 0; g < 4; ++g) den += expf(gl[g] - gmax);
        const float gwt = 1.f / den;
        float el[8];
#pragma unroll
        for (int e = 0; e < 8; ++e) el[e] = 0.f;
#pragma unroll
        for (int j = 0; j < 4; ++j) { const int c = j * 256 + lane * 4; const float yy[4] = {v[j].x, v[j].y, v[j].z, v[j].w};
#pragma unroll
            for (int i = 0; i < 4; ++i) { const float* wp = p.wre + (size_t)(c + i) * 32 + gs * 8; const float4 w0 = *(const float4*)wp, w1 = *(const float4*)(wp + 4);
                el[0] += yy[i] * w0.x; el[1] += yy[i] * w0.y; el[2] += yy[i] * w0.z; el[3] += yy[i] * w0.w; el[4] += yy[i] * w1.x; el[5] += yy[i] * w1.y; el[6] += yy[i] * w1.z; el[7] += yy[i] * w1.w; } }
#pragma unroll
        for (int e = 0; e < 8; ++e) { float s = el[e];
#pragma unroll
            for (int o = 1; o < 64; o <<= 1) s += __shfl_xor(s, o); el[e] = s + p.bre[gs * 8 + e]; }
        int i0 = 0; float v0 = el[0];
#pragma unroll
        for (int e = 1; e < 8; ++e) if (el[e] > v0) { v0 = el[e]; i0 = e; }
        int i1 = -1; float v1 = -3.0e38f;
#pragma unroll
        for (int e = 0; e < 8; ++e) if (e != i0 && el[e] > v1) { v1 = el[e]; i1 = e; }
        if (lane == 0) {
            const float w0 = 1.f / (1.f + expf(v1 - v0)), w1 = 1.f - w0;
            const int e0 = gs * 8 + i0, e1 = gs * 8 + i1;
            p.route[r] = make_int4(e0, e1, 0, 0); p.rw[r] = make_float2(w0 * gwt, w1 * gwt);
            atomicAdd(&p.cnt[e0], 1u); atomicAdd(&p.cnt[e1], 1u);
        }
    }
}
constexpr int MB = 8;
__device__ __forceinline__ void p_dispatch(LAS unsigned char* lds, int4* route, const unsigned* cnt, unsigned* cur, int* sorted) {
    LAS unsigned* off = (LAS unsigned*)lds;
    if (threadIdx.x == 0) { unsigned o = 0; for (int e = 0; e < 32; ++e) { off[e] = o; o += (cnt[e] + MB - 1) / MB * MB; } off[32] = o; }
    __syncthreads();
    for (int r = blockIdx.x * NTHR + threadIdx.x; r < T; r += gridDim.x * NTHR) {
        int4 rt = route[r];
        const unsigned s0 = off[rt.x] + atomicAdd(&cur[rt.x], 1u), s1 = off[rt.y] + atomicAdd(&cur[rt.y], 1u);
        sorted[s0] = r; sorted[s1] = r; rt.z = (int)s0; rt.w = (int)s1; route[r] = rt;
    }
    __syncthreads();
}
__device__ __forceinline__ void p_expert_naive(LAS unsigned char* lds, const bf16* H2, const int* sorted, const unsigned* cnt, const float* wg, const float* wu, const float* wd, float* YS) {
    LAS float* xs = LDSF(0);
    LAS float* hs = LDSF(MB * 4096);
    LAS unsigned* off = (LAS unsigned*)(lds + MB * 4096 + MB * 1024);
    LAS int* toks = (LAS int*)(lds + MB * 4096 + MB * 1024 + 256);
    const int t = threadIdx.x;
    if (t == 0) { unsigned o = 0; for (int e = 0; e < 32; ++e) { off[e] = o; o += (cnt[e] + MB - 1) / MB * MB; } off[32] = o; }
    __syncthreads();
    const int nblk = (int)(off[32] / MB);
    for (int vb = blockIdx.x; vb < nblk; vb += gridDim.x) {
        const unsigned s0 = vb * MB;
        int e = 0; while (off[e + 1] <= s0) ++e;
        const unsigned rem = cnt[e] - (s0 - off[e]); const unsigned nreal = rem > (unsigned)MB ? (unsigned)MB : rem;
        __syncthreads();
        if (t < MB) toks[t] = t < (int)nreal ? sorted[s0 + t] : -1;
        __syncthreads();
        for (int i = t; i < MB * 1024; i += NTHR) { const int m = i >> 10, c = i & 1023; xs[i] = toks[m] >= 0 ? bf2f(H2[(size_t)toks[m] * D + c]) : 0.f; }
        __syncthreads();
        { const int j = t & 255, hm = t >> 8;
          float ag[4], au[4];
#pragma unroll
          for (int i = 0; i < 4; ++i) { ag[i] = 0.f; au[i] = 0.f; }
          const float* pg = wg + (size_t)e * 1024 * 256 + j; const float* pu = wu + (size_t)e * 1024 * 256 + j;
          for (int k = 0; k < 1024; ++k) { const float g = pg[(size_t)k * 256], u = pu[(size_t)k * 256];
#pragma unroll
              for (int i = 0; i < 4; ++i) { const float x = xs[(hm * 4 + i) * 1024 + k]; ag[i] += x * g; au[i] += x * u; } }
#pragma unroll
          for (int i = 0; i < 4; ++i) hs[(hm * 4 + i) * 256 + j] = silu_f(ag[i]) * au[i]; }
        __syncthreads();
        { float acc[MB][2];
#pragma unroll
          for (int m = 0; m < MB; ++m) { acc[m][0] = 0.f; acc[m][1] = 0.f; }
          const float* pd = wd + (size_t)e * 256 * 1024;
          for (int j = 0; j < 256; ++j) { const float d0 = pd[(size_t)j * 1024 + t], d1 = pd[(size_t)j * 1024 + 512 + t];
#pragma unroll
              for (int m = 0; m < MB; ++m) { const float hv = hs[m * 256 + j]; acc[m][0] += hv * d0; acc[m][1] += hv * d1; } }
#pragma unroll
          for (int m = 0; m < MB; ++m) { YS[(size_t)(s0 + m) * 1024 + t] = acc[m][0]; YS[(size_t)(s0 + m) * 1024 + 512 + t] = acc[m][1]; } }
    }
    __syncthreads();
}
__device__ __forceinline__ void p_final(const float* H1, const float* YS, const int4* route, const float2* rw, const float* ada, const float* gfin, float* out) {
    const int lane = threadIdx.x & 63, gw = blockIdx.x * (NTHR / 64) + (threadIdx.x >> 6), ngw = gridDim.x * (NTHR / 64);
    for (int r = gw; r < T; r += ngw) {
        const int4 rt = route[r]; const float2 w = rw[r]; const float* g2 = ada + (r / L) * 6144 + 5120;
        float4 v[4]; float ss = 0.f;
#pragma unroll
        for (int j = 0; j < 4; ++j) { const int c = j * 256 + lane * 4;
            const float4 y0 = *(const float4*)(YS + (size_t)rt.z * 1024 + c), y1 = *(const float4*)(YS + (size_t)rt.w * 1024 + c), hh = *(const float4*)(H1 + (size_t)r * D + c), g = *(const float4*)(g2 + c);
            v[j].x = hh.x + g.x * (w.x * y0.x + w.y * y1.x); v[j].y = hh.y + g.y * (w.x * y0.y + w.y * y1.y); v[j].z = hh.z + g.z * (w.x * y0.z + w.y * y1.z); v[j].w = hh.w + g.w * (w.x * y0.w + w.y * y1.w);
            ss += v[j].x * v[j].x + v[j].y * v[j].y + v[j].z * v[j].z + v[j].w * v[j].w; }
#pragma unroll
        for (int o = 1; o < 64; o <<= 1) ss += __shfl_xor(ss, o);
        const float rstd = rsqrtf(ss * (1.f / D) + EPS);
#pragma unroll
        for (int j = 0; j < 4; ++j) { const int c = j * 256 + lane * 4; const float4 g = *(const float4*)(gfin + c);
            float4 o4; o4.x = v[j].x * rstd * g.x; o4.y = v[j].y * rstd * g.y; o4.z = v[j].z * rstd * g.z; o4.w = v[j].w * rstd * g.w;
            *(float4*)(out + (size_t)r * D + c) = o4; }
    }
}
#define GAS __attribute__((address_space(1)))
typedef unsigned v4u __attribute__((ext_vector_type(4)));
typedef unsigned v2u __attribute__((ext_vector_type(2)));
typedef short bf16x8 __attribute__((ext_vector_type(8)));
typedef float f32x16 __attribute__((ext_vector_type(16)));
typedef float f32x4 __attribute__((ext_vector_type(4)));
#define LDS_WAIT() asm volatile("s_waitcnt lgkmcnt(0)" ::: "memory")
__device__ __forceinline__ unsigned pk2(float lo, float hi) { return pg8::cvt_pk_bf16(lo, hi); }

__host__ __device__ __forceinline__ int rope_sigma_inv(int a) { const int head = a >> 7, half = (a >> 6) & 1, jj = a & 63, j = jj & 31, hi = jj >> 5; const int u = head * 64 + half * 32 + j; return (u >> 2) * 8 + (u & 3) + 4 * hi; }
struct RowMapWin {
    bf16* main_; bf16* lr; bf16* m;
    __device__ __forceinline__ bf16* operator()(int s) const {
        if (s < 3072) return main_ + (size_t)s * 1024;
        if (s < 3104) return lr + (size_t)(s - 3072) * 1024;
        if (s < 6176) { int n = s - 32; const int tile = n >> 8; if (tile >= 12 && tile < 16) n = (n & ~255) + rope_sigma_inv(n & 255); return main_ + (size_t)n * 1024; }
        return m + (size_t)(s - 6176) * 1024;
    }
};
struct RowMapId { bf16* base; int K; __device__ __forceinline__ bf16* operator()(int s) const { return base + (size_t)s * K; } };
template <class RowMap> __device__ __forceinline__ void cvt_item(const float* W, int N, LAS float* scr, int item, int lane, const RowMap& rm) {
    const int nblk = N / 32, kb = item / nblk, nb = item % nblk, k0 = 64 * kb, n0 = 32 * nb;
#pragma unroll 8
    for (int i = 0; i < 32; ++i) { const int kk = 2 * i + (lane >> 5); scr[kk * 33 + (lane & 31)] = W[(size_t)(k0 + kk) * N + n0 + (lane & 31)]; }
    LDS_WAIT();
    const int c = lane & 7;
#pragma unroll
    for (int j = 0; j < 4; ++j) { const int n = (lane >> 3) + 8 * j; const LAS float* s = scr + (8 * c) * 33 + n;
        v4u o; o.x = pk2(s[0 * 33], s[1 * 33]); o.y = pk2(s[2 * 33], s[3 * 33]); o.z = pk2(s[4 * 33], s[5 * 33]); o.w = pk2(s[6 * 33], s[7 * 33]);
        *(v4u*)(rm(n0 + n) + k0 + 8 * c) = o; }
    LDS_WAIT();
}
__device__ __forceinline__ void p_convert_weights(LAS unsigned char* lds, const float* w_in, const float* wbg, const float* wbr, const float* w_out, bf16* WinT_main, bf16* WinT_lr, bf16* WinT_m, bf16* WbgT, bf16* WbrT, bf16* WoutT) {
    const int wave = threadIdx.x >> 6, lane = threadIdx.x & 63;
    LAS float* scr = (LAS float*)(lds + 32768 + wave * 12288);
    const int gw = blockIdx.x * 8 + wave, NGW = gridDim.x * 8;
    constexpr int I_IN = 16 * (INW / 32), I_SQ = 16 * 32;
    for (int it = gw; it < I_IN + 3 * I_SQ; it += NGW) {
        int r = it;
        if (r < I_IN) { RowMapWin rm{WinT_main, WinT_lr, WinT_m}; cvt_item(w_in, INW, scr, r, lane, rm); continue; } r -= I_IN;
        if (r < I_SQ) { RowMapId rm{WbgT, 1024}; cvt_item(wbg, 1024, scr, r, lane, rm); continue; } r -= I_SQ;
        if (r < I_SQ) { RowMapId rm{WbrT, 1024}; cvt_item(wbr, 1024, scr, r, lane, rm); continue; } r -= I_SQ;
        { RowMapId rm{WoutT, 1024}; cvt_item(w_out, 1024, scr, r, lane, rm); }
    }
}
using pg8::Unit;
struct EpiProjF {
    static constexpr bool PERM = true, AFTER_DRAIN = false;
    bf16 *GQ, *GK, *GV, *GG, *RQ, *RK, *RV, *RG; const float2* rope;
    __device__ __forceinline__ void operator()(const f32x4 (&acc)[2][2][4][2], const Unit& u, int wr, int wc, int fr, int fq) const {
        const float s = 0.08838834764831845f;
        const int pn = u.pn; bf16* base; int ld, tile0; float scale = 1.f; bool isrope = false;
        if (pn < 2) { base = GQ; ld = 512; tile0 = 0; scale = s; }
        else if (pn < 4) { base = GK; ld = 512; tile0 = 2; }
        else if (pn < 8) { base = GV; ld = 1024; tile0 = 4; }
        else if (pn < 12) { base = GG; ld = 1024; tile0 = 8; }
        else if (pn < 14) { base = RQ; ld = 512; tile0 = 12; isrope = true; }
        else if (pn < 16) { base = RK; ld = 512; tile0 = 14; scale = s; isrope = true; }
        else if (pn < 20) { base = RV; ld = 1024; tile0 = 16; }
        else { base = RG; ld = 1024; tile0 = 20; }
        const int colt = (pn - tile0) * 256, row0 = u.pm * 256 + wr * 64 + fr;
        if (!isrope) {
#pragma unroll
            for (int ai = 0; ai < 2; ++ai)
#pragma unroll
                for (int m = 0; m < 4; ++m) { bf16* rowp = base + (size_t)(row0 + ai * 128 + m * 16) * ld + colt + wc * 32 + 8 * fq;
#pragma unroll
                    for (int bj = 0; bj < 2; ++bj) { const f32x4 v0 = acc[ai][bj][m][0] * scale, v1 = acc[ai][bj][m][1] * scale;
                        v4u w; w.x = pk2(v0[0], v0[1]); w.y = pk2(v0[2], v0[3]); w.z = pk2(v1[0], v1[1]); w.w = pk2(v1[2], v1[3]);
                        *(v4u*)(rowp + bj * 128) = w; } }
        } else {
#pragma unroll
            for (int ai = 0; ai < 2; ++ai)
#pragma unroll
                for (int m = 0; m < 4; ++m) { const int r = row0 + ai * 128 + m * 16; const bool lat = r < T; const int l = r & (L - 1);
#pragma unroll
                    for (int bj = 0; bj < 2; ++bj) { const int c0 = 128 * bj + 32 * wc + 8 * fq, u4 = (c0 >> 3) * 4, head = u4 >> 6, half = (u4 >> 5) & 1, j = u4 & 31;
                        const f32x4 v0 = acc[ai][bj][m][0] * scale, v1 = acc[ai][bj][m][1] * scale;
                        f32x4 o1 = v0, o2 = v1;
                        if (lat) { const int pos = half ? (l & 63) : (l >> 6); const float2* cs = rope + pos * 32 + j;
#pragma unroll
                            for (int i = 0; i < 4; ++i) { const float2 t = cs[i]; o1[i] = v0[i] * t.x - v1[i] * t.y; o2[i] = v0[i] * t.y + v1[i] * t.x; } }
                        bf16* p = base + (size_t)r * 512 + colt + head * 128 + half * 64 + j;
                        v2u w1; w1.x = pk2(o1[0], o1[1]); w1.y = pk2(o1[2], o1[3]); v2u w2; w2.x = pk2(o2[0], o2[1]); w2.y = pk2(o2[2], o2[3]);
                        *(v2u*)p = w1; *(v2u*)(p + 32) = w2; } }
        }
    }
};
struct ProjOrder {
    pg8::StaticOrder so; int G, c;
    __device__ __forceinline__ void init(int G_, int c_) { so.init(T, 6144, G_, c_); G = G_; c = c_; }
    __device__ __forceinline__ bool next(int i, Unit& u) const {
        const int Lx = i * G + c;
        if (Lx < 1536) return so.next(i, u);
        const int j = Lx - 1536; if (j >= 24) return false;
        const int t = j % 12; u.pm = 64 + j / 12; u.pn = t < 2 ? 2 + t : t < 6 ? 4 + (t - 2) : t < 8 ? 14 + (t - 6) : 16 + (t - 8); return true;
    }
    __device__ __forceinline__ void a_ready(const Unit&) const {}
    __device__ __forceinline__ void done(const Unit&) const {}
};
__device__ __forceinline__ float sigmoid_f(float v) { return 1.f / (1.f + __expf(-v)); }
template <int MODE  > struct EpiMerge {
    static constexpr bool PERM = true, AFTER_DRAIN = false;
    bf16* Y; const bf16* S2;
    __device__ __forceinline__ void operator()(const f32x4 (&acc)[2][2][4][2], const Unit& u, int wr, int wc, int fr, int fq) const {
        const int row0 = u.pm * 256 + wr * 64 + fr, col0 = u.pn * 256 + wc * 32 + 8 * fq;
#pragma unroll
        for (int ai = 0; ai < 2; ++ai)
#pragma unroll
            for (int m = 0; m < 4; ++m) { const size_t ro = (size_t)(row0 + ai * 128 + m * 16) * 1024 + col0;
#pragma unroll
                for (int bj = 0; bj < 2; ++bj) { const f32x4 a0 = acc[ai][bj][m][0], a1 = acc[ai][bj][m][1]; float o[8];
                    if (MODE == 0) {
#pragma unroll
                        for (int i = 0; i < 4; ++i) { o[i] = sigmoid_f(a0[i]); o[4 + i] = sigmoid_f(a1[i]); }
                    } else {
                        const v4u yv = *(const v4u*)(Y + ro + bj * 128); const unsigned yw[4] = {yv.x, yv.y, yv.z, yv.w}; float y[8];
#pragma unroll
                        for (int i = 0; i < 4; ++i) { y[2 * i] = __uint_as_float(yw[i] << 16); y[2 * i + 1] = __uint_as_float(yw[i] & 0xffff0000u); }
                        if (MODE == 1) {
#pragma unroll
                            for (int i = 0; i < 4; ++i) { o[i] = y[i] * a0[i]; o[4 + i] = y[4 + i] * a1[i]; }
                        } else {
                            const v4u sv = *(const v4u*)(S2 + ro + bj * 128); const unsigned sw[4] = {sv.x, sv.y, sv.z, sv.w}; float sg[8];
#pragma unroll
                            for (int i = 0; i < 4; ++i) { sg[2 * i] = __uint_as_float(sw[i] << 16); sg[2 * i + 1] = __uint_as_float(sw[i] & 0xffff0000u); }
#pragma unroll
                            for (int i = 0; i < 4; ++i) { o[i] = y[i] + sg[i] * a0[i]; o[4 + i] = y[4 + i] + sg[4 + i] * a1[i]; }
                        }
                    }
                    v4u w; w.x = pk2(o[0], o[1]); w.y = pk2(o[2], o[3]); w.z = pk2(o[4], o[5]); w.w = pk2(o[6], o[7]);
                    *(v4u*)(Y + ro + bj * 128) = w; } }
    }
};
struct EpiOutF {
    static constexpr bool PERM = false, AFTER_DRAIN = false;
    const float* x; const float* ada; float* H1;
    __device__ __forceinline__ void operator()(const f32x4 (&acc)[2][2][4][2], const Unit& u, int wr, int wc, int fr, int fq) const {
        const int row0 = u.pm * 256 + wr * 64 + fr, col0 = u.pn * 256 + wc * 32 + 4 * fq;
        const float* g1 = ada + ((u.pm * 256) / L) * 6144 + 2048;
        f32x4 gv[2][2];
#pragma unroll
        for (int bj = 0; bj < 2; ++bj)
#pragma unroll
            for (int n = 0; n < 2; ++n) gv[bj][n] = *(const f32x4*)(g1 + col0 + bj * 128 + n * 16);
#pragma unroll
        for (int ai = 0; ai < 2; ++ai)
#pragma unroll
            for (int m = 0; m < 4; ++m) { const size_t ro = (size_t)(row0 + ai * 128 + m * 16) * 1024 + col0;
#pragma unroll
                for (int bj = 0; bj < 2; ++bj)
#pragma unroll
                    for (int n = 0; n < 2; ++n) { const f32x4 xv = *(const f32x4*)(x + ro + bj * 128 + n * 16); *(f32x4*)(H1 + ro + bj * 128 + n * 16) = xv + gv[bj][n] * acc[ai][bj][m][n]; } }
    }
};
__device__ __forceinline__ void p_lr(LAS unsigned char* lds, const bf16* HL, const bf16* Wlr, float* LR) {
    const int tid = threadIdx.x, w = tid >> 6, lane = tid & 63, r = lane & 31, h = lane >> 5;
    LAS float* red = (LAS float*)lds;
    for (int unit = blockIdx.x; unit < TT / 64; unit += gridDim.x) {
        const int row0 = unit * 64;
        f32x16 acc0, acc1;
#pragma unroll
        for (int i = 0; i < 16; ++i) { acc0[i] = 0.f; acc1[i] = 0.f; }
#pragma unroll
        for (int ks = 0; ks < 8; ++ks) { const int k = 128 * w + 16 * ks + 8 * h;
            const bf16x8 a0 = *(const bf16x8*)(HL + (size_t)(row0 + r) * 1024 + k), a1 = *(const bf16x8*)(HL + (size_t)(row0 + 32 + r) * 1024 + k), b = *(const bf16x8*)(Wlr + (size_t)r * 1024 + k);
            acc0 = __builtin_amdgcn_mfma_f32_32x32x16_bf16(a0, b, acc0, 0, 0, 0); acc1 = __builtin_amdgcn_mfma_f32_32x32x16_bf16(a1, b, acc1, 0, 0, 0); }
#pragma unroll
        for (int i = 0; i < 16; ++i) { red[((w * 2 + 0) * 16 + i) * 64 + lane] = acc0[i]; red[((w * 2 + 1) * 16 + i) * 64 + lane] = acc1[i]; }
        __syncthreads();
#pragma unroll
        for (int q = 0; q < 4; ++q) { const int o = tid + q * NTHR;
            float s = 0.f;
#pragma unroll
            for (int ww = 0; ww < 8; ++ww) s += red[ww * 2048 + o];
            const int ln = o & 63, reg = (o >> 6) & 15, tile = o >> 10; const int col = ln & 31, row = (reg & 3) + 8 * (reg >> 2) + 4 * (ln >> 5);
            LR[(size_t)(row0 + tile * 32 + row) * 32 + col] = s; }
        __syncthreads();
    }
}
typedef short s16x4 __attribute__((ext_vector_type(4)));
typedef __bf16 bf16x2v __attribute__((ext_vector_type(2)));
typedef float f32x2v __attribute__((ext_vector_type(2)));
__device__ __forceinline__ unsigned pkbf(float lo, float hi) { f32x2v f = {lo, hi}; return __builtin_bit_cast(unsigned, __builtin_convertvector(f, bf16x2v)); }
__device__ __forceinline__ float bflo(unsigned w) { return __uint_as_float(w << 16); }
__device__ __forceinline__ float bfhi(unsigned w) { return __uint_as_float(w & 0xffff0000u); }
constexpr int QP = 272, VP = 528, PP = 144;
constexpr int SC_QT = 0, SC_KT = 17408, SC_V = 34816, SC_P = 68608, SC_E = 77824, SC_LR = 78336, SC_PRE = 82432, SC_WG = 86528, SC_BG = 94720, SC_END = 95232;
constexpr int OPITCH = 1040;
constexpr int ST_WORDS = 16384;
struct ScanBufs { const bf16 *GQ, *GK, *GV, *RQ, *RK, *RV; bf16 *GG, *RG; const float *LR, *lrw, *lrb, *gnorm; unsigned* ST; float* DD; unsigned* OFT; };
__device__ __forceinline__ int crow(int reg, int h) { return (reg & 3) + 8 * (reg >> 2) + 4 * h; }

template <bool NEED_Q> __device__ __forceinline__ f32x2v scan_prep(LAS unsigned char* lds, const bf16* Qh, const bf16* Kh, const bf16* Vh, const float* LRd, size_t row0, int mixer, int dir, float lg) {
    int tid = threadIdx.x; asm volatile("" : "+v"(tid));
    const int w = __builtin_amdgcn_readfirstlane(tid >> 6), dkp = tid & 63;
    unsigned qw[8], kw[8];
#pragma unroll
    for (int i = 0; i < 8; ++i) { const size_t r = row0 + 8 * w + i; kw[i] = ((const unsigned*)(Kh + r * 512))[dkp]; if (NEED_Q) qw[i] = ((const unsigned*)(Qh + r * 512))[dkp]; }
#pragma unroll
    for (int j = 0; j < 4; ++j) { const int p = tid + NTHR * j, row = p >> 5, pc = p & 31; const v4u vv = *(const v4u*)(Vh + (row0 + row) * 1024 + pc * 8); *(LAS v4u*)(lds + SC_V + row * VP + pc * 16) = vv; }
    if (mixer == 0) {
#pragma unroll
        for (int j = 0; j < 2; ++j) { const int e = tid + NTHR * j, t = e >> 4, r = e & 15; ((LAS float*)(lds + SC_LR))[e] = LRd[(row0 + t) * 32 + r]; }
    }
    __syncthreads();
    f32x2v la[8];
    if (mixer == 0) {
#pragma unroll
        for (int i = 0; i < 8; ++i) { const LAS f32x4* lr4 = (const LAS f32x4*)(lds + SC_LR + (8 * w + i) * 64); f32x2v z = ((const LAS f32x2v*)(lds + SC_BG))[dkp];
#pragma unroll
            for (int r4 = 0; r4 < 4; ++r4) { const f32x4 xx = lr4[r4]; const LAS f32x2v* wgp = (const LAS f32x2v*)(lds + SC_WG) + (4 * r4) * 64 + dkp;
                z += wgp[0] * xx[0]; z += wgp[64] * xx[1]; z += wgp[128] * xx[2]; z += wgp[192] * xx[3]; }
            f32x2v ls; ls.x = fminf(z.x, 0.f) - __logf(1.f + __expf(-fabsf(z.x))); ls.y = fminf(z.y, 0.f) - __logf(1.f + __expf(-fabsf(z.y)));
            la[i] = ls * (1.f / 16.f); }
    } else {
#pragma unroll
        for (int i = 0; i < 8; ++i) { la[i].x = lg; la[i].y = lg; }
    }
    if (dir == 0) {
#pragma unroll
        for (int i = 1; i < 8; ++i) la[i] += la[i - 1];
    } else {
#pragma unroll
        for (int i = 6; i >= 0; --i) la[i] += la[i + 1];
    }
    ((LAS f32x2v*)(lds + SC_PRE))[w * 64 + dkp] = dir == 0 ? la[7] : la[0];
    __syncthreads();
    f32x2v off = {0.f, 0.f}, tot = {0.f, 0.f};
#pragma unroll
    for (int w2 = 0; w2 < 8; ++w2) { const f32x2v p = ((const LAS f32x2v*)(lds + SC_PRE))[w2 * 64 + dkp]; tot += p; if (dir == 0 ? (w2 < w) : (w2 > w)) off += p; }
#pragma unroll
    for (int i = 0; i < 8; ++i) { const f32x2v Bv = la[i] + off; const int t = 8 * w + i;
        const float e0 = __expf(-Bv.x), e1 = __expf(-Bv.y);
        *(LAS unsigned*)(lds + SC_KT + t * QP + dkp * 4) = pkbf(bflo(kw[i]) * e0, bfhi(kw[i]) * e1);
        if (NEED_Q) { const float f0 = __expf(Bv.x), f1 = __expf(Bv.y); *(LAS unsigned*)(lds + SC_QT + t * QP + dkp * 4) = pkbf(bflo(qw[i]) * f0, bfhi(qw[i]) * f1); } }
    if (w == 0) { f32x2v ev; ev.x = __expf(tot.x); ev.y = __expf(tot.y); ((LAS f32x2v*)(lds + SC_E))[dkp] = ev; }
    __syncthreads();
    return tot;
}
__device__ __forceinline__ bf16x8 scan_vfrag(LAS unsigned char* lds, int w, int lane, int s) {
    const int h = lane >> 5, blk = (lane >> 4) & 1, q4 = (lane & 15) >> 2, p4 = lane & 3;
    const s16x4 a = __builtin_amdgcn_ds_read_tr16_b64_v4i16((LAS s16x4*)(lds + SC_V + VP * (16 * s + 8 * h + q4) + 64 * w + 32 * blk + 8 * p4));
    const s16x4 b = __builtin_amdgcn_ds_read_tr16_b64_v4i16((LAS s16x4*)(lds + SC_V + VP * (16 * s + 8 * h + 4 + q4) + 64 * w + 32 * blk + 8 * p4));
    return (bf16x8){a[0], a[1], a[2], a[3], b[0], b[1], b[2], b[3]};
}
__device__ __forceinline__ void scan_update(LAS unsigned char* lds, int w, int lane, f32x16 (&S)[4]) {
    const int h = lane >> 5, blk = (lane >> 4) & 1, q4 = (lane & 15) >> 2, p4 = lane & 3;
#pragma unroll
    for (int s = 0; s < 4; ++s) {
        const bf16x8 vf = scan_vfrag(lds, w, lane, s);
#pragma unroll
        for (int i = 0; i < 4; ++i) {
            const s16x4 a = __builtin_amdgcn_ds_read_tr16_b64_v4i16((LAS s16x4*)(lds + SC_KT + QP * (16 * s + 8 * h + q4) + 64 * i + 32 * blk + 8 * p4));
            const s16x4 b = __builtin_amdgcn_ds_read_tr16_b64_v4i16((LAS s16x4*)(lds + SC_KT + QP * (16 * s + 8 * h + 4 + q4) + 64 * i + 32 * blk + 8 * p4));
            const bf16x8 ak = (bf16x8){a[0], a[1], a[2], a[3], b[0], b[1], b[2], b[3]};
            S[i] = __builtin_amdgcn_mfma_f32_32x32x16_bf16(ak, vf, S[i], 0, 0, 0); }
    }
#pragma unroll
    for (int i = 0; i < 4; ++i)
#pragma unroll
        for (int g = 0; g < 4; ++g) { const f32x4 ev = *(const LAS f32x4*)(lds + SC_E + (32 * i + 8 * g + 4 * h) * 4);
#pragma unroll
            for (int j = 0; j < 4; ++j) S[i][4 * g + j] *= ev[j]; }
}
__device__ __forceinline__ void scan_load_state(const unsigned* st, int w, int lane, f32x16 (&S)[4]) {
#pragma unroll
    for (int i = 0; i < 4; ++i)
#pragma unroll
        for (int rp = 0; rp < 8; ++rp) { const unsigned u = st[((w * 4 + i) * 8 + rp) * 64 + lane]; S[i][2 * rp] = bflo(u); S[i][2 * rp + 1] = bfhi(u); }
}
__device__ __forceinline__ void scan_store_state(unsigned* st, int w, int lane, const f32x16 (&S)[4]) {
#pragma unroll
    for (int i = 0; i < 4; ++i)
#pragma unroll
        for (int rp = 0; rp < 8; ++rp) st[((w * 4 + i) * 8 + rp) * 64 + lane] = pkbf(S[i][2 * rp], S[i][2 * rp + 1]);
}
__device__ __forceinline__ void scan_gate_weights(LAS unsigned char* lds, const ScanBufs& p, int mixer, int dir, int h) {
    if (mixer == 0) {
        for (int e = threadIdx.x; e < 16 * 128; e += NTHR) { const int r = e >> 7, c = e & 127; ((LAS float*)(lds + SC_WG))[e] = p.lrw[(size_t)(dir * 16 + r) * 512 + h * 128 + c]; }
        if (threadIdx.x < 128) ((LAS float*)(lds + SC_BG))[threadIdx.x] = p.lrb[dir * 512 + h * 128 + threadIdx.x];
    }
}
__device__ __forceinline__ void p_scan_a(LAS unsigned char* lds, const ScanBufs& p) {
    for (int unit = blockIdx.x; unit < 512; unit += gridDim.x) {
        int tid = threadIdx.x; asm volatile("" : "+v"(tid));
        const int w = __builtin_amdgcn_readfirstlane(tid >> 6), lane = tid & 63, dkp = tid & 63;
        const int chain = unit >> 4, slot = unit & 15, dir = chain & 1, h = (chain >> 1) & 3, b = (chain >> 3) & 1, mixer = chain >> 4;
        const bf16* Kh = (mixer ? p.RK : p.GK) + h * 128; const bf16* Vh = (mixer ? p.RV : p.GV) + h * 256; const float* LRd = p.LR + dir * 16;
        const float lg = log1pf(-exp2f(-(dir ? 5.5f : 5.0f) - (float)h));
        scan_gate_weights(lds, p, mixer, dir, h);
        const int nch = slot == 0 ? 4 : 8;
        const int seg = dir == 0 ? slot - 1 : 16 - slot;
        const size_t base = slot == 0 ? (size_t)T + b * CTX : (size_t)b * L + seg * 512;
        f32x16 S[4];
#pragma unroll
        for (int i = 0; i < 4; ++i)
#pragma unroll
            for (int j = 0; j < 16; ++j) S[i][j] = 0.f;
        f32x2v dsum = {0.f, 0.f};
        for (int cc = 0; cc < nch; ++cc) {
            const int chunk = dir == 0 ? cc : nch - 1 - cc;
            const f32x2v tot = scan_prep<false>(lds, nullptr, Kh, Vh, LRd, base + chunk * 64, mixer, dir, lg);
            dsum += tot;
            scan_update(lds, w, lane, S);
            __syncthreads();
        }
        scan_store_state(p.ST + (size_t)(chain * 16 + slot) * ST_WORDS, w, lane, S);
        if (w == 0) { f32x2v dv; dv.x = __expf(dsum.x); dv.y = __expf(dsum.y); *(f32x2v*)(p.DD + (size_t)(chain * 16 + slot) * 128 + 2 * dkp) = dv; }
    }
}
__device__ __forceinline__ void p_scan_b(const ScanBufs& p) {
    for (int e = blockIdx.x * NTHR + threadIdx.x; e < 32 * ST_WORDS; e += gridDim.x * NTHR) {
        const int chain = e / ST_WORDS, wi = e % ST_WORDS; const int lane = wi & 63, rp = (wi >> 6) & 7, i = (wi >> 9) & 3;
        const int dk0 = 32 * i + crow(2 * rp, lane >> 5);
        unsigned* st = p.ST + (size_t)chain * 16 * ST_WORDS + wi; const float* dd = p.DD + (size_t)chain * 16 * 128 + dk0;
        unsigned u = st[0]; float s0 = bflo(u), s1 = bfhi(u);
#pragma unroll 5
        for (int j = 1; j < 16; ++j) { const unsigned uu = st[(size_t)j * ST_WORDS]; const f32x2v d = *(const f32x2v*)(dd + j * 128);
            s0 = d.x * s0 + bflo(uu); s1 = d.y * s1 + bfhi(uu); st[(size_t)j * ST_WORDS] = pkbf(s0, s1); }
    }
}
__device__ __forceinline__ void p_scan_c(LAS unsigned char* lds, const ScanBufs& p) {
    for (int unit = blockIdx.x; unit < 256; unit += gridDim.x) {
        int tid = threadIdx.x; asm volatile("" : "+v"(tid));
        const int w = __builtin_amdgcn_readfirstlane(tid >> 6), lane = tid & 63, r = lane & 31, h2 = lane >> 5;
        const int mixer = unit >> 7, b = (unit >> 6) & 1, h = (unit >> 4) & 3, seg = unit & 15;
        const bf16* Qh = (mixer ? p.RQ : p.GQ) + h * 128; const bf16* Kh = (mixer ? p.RK : p.GK) + h * 128; const bf16* Vh = (mixer ? p.RV : p.GV) + h * 256;
        bf16* Gh = (mixer ? p.RG : p.GG) + h * 256;
        unsigned* oft = p.OFT + (size_t)unit * 65536;
        const size_t base = (size_t)b * L + seg * 512;
        for (int dir = 0; dir < 2; ++dir) {
            const int chain = ((mixer * 2 + b) * 4 + h) * 2 + dir, slot = dir == 0 ? seg : 15 - seg;
            const float lg = log1pf(-exp2f(-(dir ? 5.5f : 5.0f) - (float)h));
            scan_gate_weights(lds, p, mixer, dir, h);
            f32x16 S[4]; scan_load_state(p.ST + (size_t)(chain * 16 + slot) * ST_WORDS, w, lane, S);
            for (int cc = 0; cc < 8; ++cc) {
                const int chunk = dir == 0 ? cc : 7 - cc; const size_t row0 = base + chunk * 64;
                scan_prep<true>(lds, Qh, Kh, Vh, p.LR + dir * 16, row0, mixer, dir, lg);
                { const int lr = lane & 15, lq = lane >> 4;
#pragma unroll
                  for (int tt = 0; tt < 2; ++tt) { const int id = 2 * w + tt, ti16 = id >> 2, si16 = id & 3; f32x4 acc = {0.f, 0.f, 0.f, 0.f};
#pragma unroll
                      for (int kk = 0; kk < 4; ++kk) { const bf16x8 a = *(const LAS bf16x8*)(lds + SC_KT + (16 * si16 + lr) * QP + (kk * 32 + 8 * lq) * 2), bq = *(const LAS bf16x8*)(lds + SC_QT + (16 * ti16 + lr) * QP + (kk * 32 + 8 * lq) * 2);
                          acc = __builtin_amdgcn_mfma_f32_16x16x32_bf16(a, bq, acc, 0, 0, 0); }
                      const int t = 16 * ti16 + lr, s0 = 16 * si16 + 4 * lq; float pv[4];
#pragma unroll
                      for (int j = 0; j < 4; ++j) { const int s = s0 + j; const bool keep = dir == 0 ? (s <= t) : (s > t); pv[j] = keep ? acc[j] : 0.f; }
                      v2u pw; pw.x = pkbf(pv[0], pv[1]); pw.y = pkbf(pv[2], pv[3]); *(LAS v2u*)(lds + SC_P + t * PP + s0 * 2) = pw; } }
                __syncthreads();
                f32x16 o[2];
#pragma unroll
                for (int ti = 0; ti < 2; ++ti)
#pragma unroll
                    for (int j = 0; j < 16; ++j) o[ti][j] = 0.f;
#pragma unroll
                for (int i = 0; i < 4; ++i)
#pragma unroll
                    for (int s2 = 0; s2 < 2; ++s2) {
                        v4u sbw; sbw.x = pkbf(S[i][8 * s2], S[i][8 * s2 + 1]); sbw.y = pkbf(S[i][8 * s2 + 2], S[i][8 * s2 + 3]); sbw.z = pkbf(S[i][8 * s2 + 4], S[i][8 * s2 + 5]); sbw.w = pkbf(S[i][8 * s2 + 6], S[i][8 * s2 + 7]);
                        const bf16x8 sb = __builtin_bit_cast(bf16x8, sbw);
#pragma unroll
                        for (int ti = 0; ti < 2; ++ti) { const LAS unsigned char* qa = lds + SC_QT + (32 * ti + r) * QP + (32 * i + 16 * s2 + 4 * h2) * 2;
                            const v2u a0 = *(const LAS v2u*)qa, a1 = *(const LAS v2u*)(qa + 16); v4u aw; aw.x = a0.x; aw.y = a0.y; aw.z = a1.x; aw.w = a1.y;
                            o[ti] = __builtin_amdgcn_mfma_f32_32x32x16_bf16(__builtin_bit_cast(bf16x8, aw), sb, o[ti], 0, 0, 0); } }
#pragma unroll
                for (int ks = 0; ks < 4; ++ks) { const bf16x8 vf = scan_vfrag(lds, w, lane, ks);
#pragma unroll
                    for (int ti = 0; ti < 2; ++ti) { const bf16x8 a = *(const LAS bf16x8*)(lds + SC_P + (32 * ti + r) * PP + (16 * ks + 8 * h2) * 2); o[ti] = __builtin_amdgcn_mfma_f32_32x32x16_bf16(a, vf, o[ti], 0, 0, 0); } }
                scan_update(lds, w, lane, S);
                if (dir == 0) {
#pragma unroll
                    for (int ti = 0; ti < 2; ++ti)
#pragma unroll
                        for (int rp = 0; rp < 8; ++rp) oft[(((chunk * 8 + w) * 2 + ti) * 8 + rp) * 64 + lane] = pkbf(o[ti][2 * rp], o[ti][2 * rp + 1]);
                } else {
                    __syncthreads();
#pragma unroll
                    for (int ti = 0; ti < 2; ++ti)
#pragma unroll
                        for (int rp = 0; rp < 8; ++rp) { const unsigned u = oft[(((chunk * 8 + w) * 2 + ti) * 8 + rp) * 64 + lane];
                            *(LAS float*)(lds + (32 * ti + crow(2 * rp, h2)) * OPITCH + (32 * w + r) * 4) = o[ti][2 * rp] + bflo(u);
                            *(LAS float*)(lds + (32 * ti + crow(2 * rp + 1, h2)) * OPITCH + (32 * w + r) * 4) = o[ti][2 * rp + 1] + bfhi(u); }
                    __syncthreads();
                    { const int t = tid >> 3, part = tid & 7; const LAS f32x4* op = (const LAS f32x4*)(lds + t * OPITCH + part * 128);
                      float s1 = 0.f, s2 = 0.f;
#pragma unroll
                      for (int x = 0; x < 8; ++x) { const f32x4 q = op[x]; s1 += (q[0] + q[1]) + (q[2] + q[3]); s2 += (q[0] * q[0] + q[1] * q[1]) + (q[2] * q[2] + q[3] * q[3]); }
#pragma unroll
                      for (int x = 1; x < 8; x <<= 1) { s1 += __shfl_xor(s1, x); s2 += __shfl_xor(s2, x); }
                      const float mu = mixer ? s1 * (1.f / 256.f) : 0.f; const float var = s2 * (1.f / 256.f) - mu * mu; const float rstd = rsqrtf(var + EPS);
                      bf16* gp = Gh + (row0 + t) * 1024 + part * 32; const float* gnp = p.gnorm + part * 32;
#pragma unroll
                      for (int x = 0; x < 4; ++x) { const v4u gw = *(const v4u*)(gp + 8 * x); const unsigned gws[4] = {gw.x, gw.y, gw.z, gw.w}; float y[8];
                          const f32x4 oa = op[2 * x], ob = op[2 * x + 1];
#pragma unroll
                          for (int e = 0; e < 8; ++e) { const float ovv = e < 4 ? oa[e & 3] : ob[e & 3]; const float g = (e & 1) ? bfhi(gws[e >> 1]) : bflo(gws[e >> 1]);
                              float yy = (ovv - mu) * rstd; if (mixer == 0) yy *= gnp[8 * x + e]; y[e] = yy * g / (1.f + __expf(-g)); }
                          v4u yw; yw.x = pkbf(y[0], y[1]); yw.y = pkbf(y[2], y[3]); yw.z = pkbf(y[4], y[5]); yw.w = pkbf(y[6], y[7]); *(v4u*)(gp + 8 * x) = yw;
                          __builtin_amdgcn_sched_barrier(0); } }
                }
                __syncthreads();
            }
        }
    }
}
constexpr int CW_TOFF = 2048;
struct RowMapGU { bf16* base; int e; int up; __device__ __forceinline__ bf16* operator()(int s) const { return base + ((size_t)e * 512 + 8 * (s >> 2) + (s & 3) + 4 * up) * 1024; } };
struct RowMapDn { bf16* base; int e; __device__ __forceinline__ bf16* operator()(int s) const { return base + ((size_t)e * 1024 + s) * 256; } };
__device__ __forceinline__ void p_convert_experts(LAS unsigned char* lds, const float* weg, const float* weu, const float* wed, bf16* E1T, bf16* WdT) {
    const int wave = threadIdx.x >> 6, lane = threadIdx.x & 63;
    LAS float* scr = (LAS float*)(lds + wave * 12288);
    const int gw = blockIdx.x * 8 + wave, NGW = gridDim.x * 8;
    for (int it = gw; it < 3 * 4096; it += NGW) {
        const int kind = it >> 12, r = it & 4095, e = r >> 7, item = r & 127;
        if (kind == 0) { RowMapGU rm{E1T, e, 0}; cvt_item(weg + (size_t)e * 1024 * 256, 256, scr, item, lane, rm); }
        else if (kind == 1) { RowMapGU rm{E1T, e, 1}; cvt_item(weu + (size_t)e * 1024 * 256, 256, scr, item, lane, rm); }
        else { RowMapDn rm{WdT, e}; cvt_item(wed + (size_t)e * 256 * 1024, 1024, scr, item, lane, rm); }
    }
}
__device__ __forceinline__ void p_dispatch2(LAS unsigned char* lds, int4* route, const unsigned* cnt, unsigned* cur, int* toff_g, const bf16* H2, bf16* H2s) {
    LAS unsigned* off = (LAS unsigned*)lds;
    if (threadIdx.x == 0) { unsigned o = 0; for (int e = 0; e < 32; ++e) { off[e] = o; if (blockIdx.x == 0) toff_g[e] = (int)(o >> 8); o += (cnt[e] + 255u) & ~255u; } off[32] = o; if (blockIdx.x == 0) toff_g[32] = (int)(o >> 8); }
    __syncthreads();
    const int lane = threadIdx.x & 63, gw = blockIdx.x * (NTHR / 64) + (threadIdx.x >> 6), ngw = gridDim.x * (NTHR / 64);
    for (int r = gw; r < T; r += ngw) {
        int4 rt = route[r]; unsigned s0 = 0, s1 = 0;
        if (lane == 0) { s0 = off[rt.x] + atomicAdd(&cur[rt.x], 1u); s1 = off[rt.y] + atomicAdd(&cur[rt.y], 1u); rt.z = (int)s0; rt.w = (int)s1; route[r] = rt; }
        s0 = __shfl(s0, 0); s1 = __shfl(s1, 0);
        const v4u a = *(const v4u*)(H2 + (size_t)r * D + lane * 8), b = *(const v4u*)(H2 + (size_t)r * D + 512 + lane * 8);
        *(v4u*)(H2s + (size_t)s0 * D + lane * 8) = a; *(v4u*)(H2s + (size_t)s0 * D + 512 + lane * 8) = b;
        *(v4u*)(H2s + (size_t)s1 * D + lane * 8) = a; *(v4u*)(H2s + (size_t)s1 * D + 512 + lane * 8) = b;
    }
    __syncthreads();
}
struct MoeOrder {
    int nct, G, c, ntiles; const LAS int* toff;
    __device__ __forceinline__ bool next(int i, Unit& u) const {
        const int Lx = i * G + c; if (Lx >= ntiles * nct) return false;
        const int rt = Lx / nct, ct = Lx - rt * nct; int e = 0; while (__builtin_amdgcn_readfirstlane(toff[e + 1]) <= rt) ++e;
        u.pm = rt; u.pn = __builtin_amdgcn_readfirstlane(e * nct + ct); return true;
    }
    __device__ __forceinline__ void a_ready(const Unit&) const {}
    __device__ __forceinline__ void done(const Unit&) const {}
};
struct EpiHid {
    static constexpr bool PERM = true, AFTER_DRAIN = false;
    bf16* HID;
    __device__ __forceinline__ void operator()(const f32x4 (&acc)[2][2][4][2], const Unit& u, int wr, int wc, int fr, int fq) const {
        const int row0 = u.pm * 256 + wr * 64 + fr, col0 = (u.pn & 1) * 128 + 16 * wc + 4 * fq;
#pragma unroll
        for (int ai = 0; ai < 2; ++ai)
#pragma unroll
            for (int m = 0; m < 4; ++m) { bf16* rowp = HID + (size_t)(row0 + ai * 128 + m * 16) * 256 + col0;
#pragma unroll
                for (int bj = 0; bj < 2; ++bj) { const f32x4 g = acc[ai][bj][m][0], uu = acc[ai][bj][m][1]; float hv[4];
#pragma unroll
                    for (int i = 0; i < 4; ++i) hv[i] = g[i] / (1.f + __expf(-g[i])) * uu[i];
                    v2u w; w.x = pk2(hv[0], hv[1]); w.y = pk2(hv[2], hv[3]); *(v2u*)(rowp + bj * 64) = w; } }
    }
};
struct EpiYs {
    static constexpr bool PERM = true, AFTER_DRAIN = false;
    bf16* YS;
    __device__ __forceinline__ void operator()(const f32x4 (&acc)[2][2][4][2], const Unit& u, int wr, int wc, int fr, int fq) const {
        const int row0 = u.pm * 256 + wr * 64 + fr, col0 = (u.pn & 3) * 256 + wc * 32 + 8 * fq;
#pragma unroll
        for (int ai = 0; ai < 2; ++ai)
#pragma unroll
            for (int m = 0; m < 4; ++m) { bf16* rowp = YS + (size_t)(row0 + ai * 128 + m * 16) * 1024 + col0;
#pragma unroll
                for (int bj = 0; bj < 2; ++bj) { const f32x4 v0 = acc[ai][bj][m][0], v1 = acc[ai][bj][m][1];
                    v4u w; w.x = pk2(v0[0], v0[1]); w.y = pk2(v0[2], v0[3]); w.z = pk2(v1[0], v1[1]); w.w = pk2(v1[2], v1[3]); *(v4u*)(rowp + bj * 128) = w; } }
    }
};
__device__ __forceinline__ void p_final2(const float* H1, const bf16* YS, const int4* route, const float2* rw, const float* ada, const float* gfin, float* out) {
    const int lane = threadIdx.x & 63, gw = blockIdx.x * (NTHR / 64) + (threadIdx.x >> 6), ngw = gridDim.x * (NTHR / 64);
    for (int r = gw; r < T; r += ngw) {
        const int4 rt = route[r]; const float2 w = rw[r]; const float* g2 = ada + (r / L) * 6144 + 5120;
        float4 v[4]; float ss = 0.f;
#pragma unroll
        for (int j = 0; j < 4; ++j) { const int c = j * 256 + lane * 4;
            const v2u y0 = *(const v2u*)(YS + (size_t)rt.z * 1024 + c), y1 = *(const v2u*)(YS + (size_t)rt.w * 1024 + c); const float4 hh = *(const float4*)(H1 + (size_t)r * D + c), g = *(const float4*)(g2 + c);
            v[j].x = hh.x + g.x * (w.x * bflo(y0.x) + w.y * bflo(y1.x)); v[j].y = hh.y + g.y * (w.x * bfhi(y0.x) + w.y * bfhi(y1.x)); v[j].z = hh.z + g.z * (w.x * bflo(y0.y) + w.y * bflo(y1.y)); v[j].w = hh.w + g.w * (w.x * bfhi(y0.y) + w.y * bfhi(y1.y));
            ss += v[j].x * v[j].x + v[j].y * v[j].y + v[j].z * v[j].z + v[j].w * v[j].w; }
#pragma unroll
        for (int o = 1; o < 64; o <<= 1) ss += __shfl_xor(ss, o);
        const float rstd = rsqrtf(ss * (1.f / D) + EPS);
#pragma unroll
        for (int j = 0; j < 4; ++j) { const int c = j * 256 + lane * 4; const float4 g = *(const float4*)(gfin + c);
            float4 o4; o4.x = v[j].x * rstd * g.x; o4.y = v[j].y * rstd * g.y; o4.z = v[j].z * rstd * g.z; o4.w = v[j].w * rstd * g.w;
            *(float4*)(out + (size_t)r * D + c) = o4; }
    }
}
#ifndef MK_N_LAUNCHES
#define MK_N_LAUNCHES 1
#endif
constexpr int NPHASE = 14;
struct Args { const float* in[23]; float* out; unsigned char* ws; int ph_lo, ph_hi; };
__global__ void __launch_bounds__(NTHR, 2) mk_fwd(Args a) {
    extern __shared__ __attribute__((aligned(16))) unsigned char lds_raw[];
    LAS unsigned char* lds = (LAS unsigned char*)lds_raw;
    const int tid = threadIdx.x;
    unsigned char* ws = a.ws;
    unsigned* ctl = (unsigned*)(ws + WS_CTL);
    if (tid < 4) ((LAS unsigned*)(lds + LDS_MISC))[tid] = 0u;
    __syncthreads();
    XcdBarrier bar; bar.bar = ctl + CW_BAR; bar.x = 0; bar.st = nullptr;
    if (a.ph_hi - a.ph_lo > 1) bar = xcd_barrier_post(ctl + CW_BAR, (volatile LAS unsigned*)(lds + LDS_MISC));
    const float* x = a.in[0]; const float* c = a.in[1]; const float* ctx = a.in[2]; const float* cctx = a.in[3];
    const float* w_ada = a.in[4]; const float* b_ada = a.in[5]; const float* norm_mix = a.in[6]; const float* norm_ffn = a.in[7];
    const float* w_in = a.in[8]; const float* lrw = a.in[9]; const float* lrb = a.in[10]; const float* gla_norm = a.in[11];
    const float* wbg = a.in[12]; const float* wbr = a.in[13]; const float* w_out = a.in[14];
    const float* wrg = a.in[15]; const float* brg = a.in[16]; const float* wre = a.in[17]; const float* bre = a.in[18];
    const float* weg = a.in[19]; const float* weu = a.in[20]; const float* wed = a.in[21]; const float* norm_final = a.in[22];
    float* ada = (float*)(ws + WS_ADA); float2* rope = (float2*)(ws + WS_ROPE); float* LR = (float*)(ws + WS_LR);
    int4* route = (int4*)(ws + WS_ROUTE); float2* rw = (float2*)(ws + WS_ROUTE + 512 * 1024); int* sorted = (int*)(ws + WS_SORT);
    bf16* GQ = (bf16*)(ws + WS_GQ); bf16* GK = (bf16*)(ws + WS_GK); bf16* RQ = (bf16*)(ws + WS_RQ); bf16* RK = (bf16*)(ws + WS_RK);
    bf16* GV = (bf16*)(ws + WS_GV); bf16* RV = (bf16*)(ws + WS_RV); bf16* GG = (bf16*)(ws + WS_GG); bf16* RG = (bf16*)(ws + WS_RG);
    bf16* WinT = (bf16*)a.out; bf16* WinT_lr = WinT + (size_t)6144 * 1024; bf16* WinT_m = (bf16*)(ws + WS_WINM);
    bf16* WbgT = (bf16*)(ws + WS_WBG); bf16* WbrT = (bf16*)(ws + WS_WBR); bf16* WoutT = (bf16*)(ws + WS_WOUT);
    bf16* HL = (bf16*)((unsigned char*)a.out + DO_HL); bf16* HL2 = (bf16*)a.out;
    float* out = a.out; bf16* OF = (bf16*)a.out; float* H1 = a.out;
    bf16* Y = (bf16*)(ws + WS_Y); bf16* S2 = (bf16*)(ws + WS_S2); bf16* H2 = (bf16*)(ws + WS_ST); bf16* YS = (bf16*)(ws + WS_YS); bf16* H2s = (bf16*)(ws + WS_YS); bf16* HID = (bf16*)(ws + WS_GG);
    bf16* E1T = (bf16*)(ws + WS_EXPW); bf16* WdT = (bf16*)(ws + WS_EXPW + 32 * MiB); int* toff_g = (int*)(ctl + CW_TOFF);
    const int lo = a.ph_lo, hi = a.ph_hi;
#define IN(k) (lo <= (k) && (k) < hi)
#define SEAM(k) do { if (IN(k) && IN((k) + 1)) xcd_barrier(bar); } while (0)
    if (IN(0)) { p_ada(lds, c, cctx, w_ada, b_ada, ada, rope); p_convert_weights(lds, w_in, wbg, wbr, w_out, WinT, WinT_lr, WinT_m, WbgT, WbrT, WoutT); } SEAM(0);
    if (IN(1)) { p_norm_mod(x, ctx, norm_mix, ada, HL, 0, TT); } SEAM(1);
    if (IN(2)) {
        pg8::Gemm g{HL, WinT, TT, 6144, 1024}; ProjOrder S; S.init((int)gridDim.x, (int)blockIdx.x);
        EpiProjF E{GQ, GK, GV, GG, RQ, RK, RV, RG, rope};
        pg8::gemm_phase<EpiProjF, ProjOrder, true, true>(lds, g, S, E);
        p_lr(lds, HL, WinT_lr, LR);
    } SEAM(2);
    ScanBufs sb{GQ, GK, GV, RQ, RK, RV, GG, RG, LR, lrw, lrb, gla_norm, (unsigned*)(ws + WS_ST), (float*)(ws + WS_ST + 33 * MiB), (unsigned*)a.out};
    if (IN(3)) { p_scan_a(lds, sb); } SEAM(3);
    if (IN(4)) { p_scan_b(sb); } SEAM(4);
    if (IN(5)) { p_scan_c(lds, sb); } SEAM(5);
    if (IN(6)) { p_norm_mod(x, ctx, norm_mix, ada, HL2, 0, T); p_convert_experts(lds, weg, weu, wed, E1T, WdT); } SEAM(6);
    if (IN(7)) {
        pg8::StaticOrder S; S.init(T, 1024, (int)gridDim.x, (int)blockIdx.x);
        { pg8::Gemm g{HL2, WinT_m, T, 1024, 1024}; EpiMerge<0> E{Y, nullptr}; pg8::gemm_phase<EpiMerge<0>, pg8::StaticOrder, false, true>(lds, g, S, E); }
        { pg8::Gemm g{GG, WbgT, T, 1024, 1024}; EpiMerge<1> E{Y, nullptr}; pg8::gemm_phase<EpiMerge<1>, pg8::StaticOrder, false, true>(lds, g, S, E); }
        { pg8::Gemm g{HL2, WinT_m + (size_t)1024 * 1024, T, 1024, 1024}; EpiMerge<0> E{S2, nullptr}; pg8::gemm_phase<EpiMerge<0>, pg8::StaticOrder, false, true>(lds, g, S, E); }
        { pg8::Gemm g{RG, WbrT, T, 1024, 1024}; EpiMerge<2> E{Y, S2}; pg8::gemm_phase<EpiMerge<2>, pg8::StaticOrder, false, true>(lds, g, S, E); }
    } SEAM(7);
    if (IN(8)) { pg8::StaticOrder S; S.init(T, 1024, (int)gridDim.x, (int)blockIdx.x); pg8::Gemm g{Y, WoutT, T, 1024, 1024}; EpiOutF E{x, ada, H1}; pg8::gemm_phase<EpiOutF, pg8::StaticOrder, false, true>(lds, g, S, E); } SEAM(8);
    if (IN(9)) { RouteP rp{H1, norm_ffn, ada, wrg, brg, wre, bre, H2, route, rw, ctl + CW_CNT}; p_norm_route(rp); } SEAM(9);
    if (IN(10)) { p_dispatch2(lds, route, ctl + CW_CNT, ctl + CW_CUR, toff_g, H2, H2s); } SEAM(10);
    if (IN(11) || IN(12)) { if (tid < 33) ((LAS int*)(lds + LDS_MISC + 64))[tid] = toff_g[tid]; __syncthreads(); }
    if (IN(11)) { MoeOrder S{2, (int)gridDim.x, (int)blockIdx.x, ((const LAS int*)(lds + LDS_MISC + 64))[32], (const LAS int*)(lds + LDS_MISC + 64)};
        pg8::Gemm g{H2s, E1T, 0, 0, 1024}; EpiHid E{HID}; pg8::gemm_phase<EpiHid, MoeOrder, true, true>(lds, g, S, E); } SEAM(11);
    if (IN(12)) { MoeOrder S{4, (int)gridDim.x, (int)blockIdx.x, ((const LAS int*)(lds + LDS_MISC + 64))[32], (const LAS int*)(lds + LDS_MISC + 64)};
        int kdn = 256; asm volatile("" : "+s"(kdn));
        pg8::Gemm g{HID, WdT, 0, 0, kdn}; EpiYs E{YS}; pg8::gemm_phase<EpiYs, MoeOrder, true, true>(lds, g, S, E); } SEAM(12);
    if (IN(13)) { p_final2(H1, YS, route, rw, ada, norm_final, out); }
#undef IN
#undef SEAM
}

extern "C" void kernel_launch(void* const* d_in, const int* in_sizes, int n_in, void* d_out, int out_size, void* d_ws, size_t ws_size, hipStream_t stream) {
    static int grid = 0;
    if (grid == 0) {
        if (n_in != 23 || ws_size < WS_END) { fprintf(stderr, "kernel_launch: unexpected n_in %d or ws %zu\n", n_in, ws_size); grid = -1; return; }
        int dev = 0, cus = 0, per_cu = 0;
        if (hipGetDevice(&dev) != hipSuccess || hipDeviceGetAttribute(&cus, hipDeviceAttributeMultiprocessorCount, dev) != hipSuccess) { grid = -1; return; }
        if (hipFuncSetAttribute((const void*)mk_fwd, hipFuncAttributeMaxDynamicSharedMemorySize, LDS_BYTES) != hipSuccess) { fprintf(stderr, "kernel_launch: hipFuncSetAttribute failed\n"); grid = -1; return; }
        if (hipOccupancyMaxActiveBlocksPerMultiprocessor(&per_cu, (const void*)mk_fwd, NTHR, LDS_BYTES) != hipSuccess || per_cu < 1) { fprintf(stderr, "kernel_launch: occupancy query says %d\n", per_cu); }
        (void)hipGetLastError();
        grid = cus;
    }
    if (grid < 0) return;
    if (hipMemsetAsync((char*)d_ws + WS_CTL, 0, 1 * MiB, stream) != hipSuccess) return;
    Args a{};
    for (int i = 0; i < 23; ++i) a.in[i] = (const float*)d_in[i];
    a.out = (float*)d_out; a.ws = (unsigned char*)d_ws;
#if MK_N_LAUNCHES == 1
    a.ph_lo = 0; a.ph_hi = NPHASE;
    hipLaunchKernelGGL(mk_fwd, dim3(grid), dim3(NTHR), LDS_BYTES, stream, a);
#else
    for (int p = 0; p < NPHASE; ++p) { a.ph_lo = p; a.ph_hi = p + 1; hipLaunchKernelGGL(mk_fwd, dim3(grid), dim3(NTHR), LDS_BYTES, stream, a); }
#endif
}
```

```cpp
#include <hip/hip_runtime.h>
#include <stdint.h>
#include <stdio.h>

typedef unsigned short bf16;
__device__ __forceinline__ float bf2f(bf16 v) { return __uint_as_float(((unsigned)v) << 16); }
__device__ __forceinline__ bf16 f2bf(float f) { unsigned u = __float_as_uint(f); return (bf16)((u + 0x7fffu + ((u >> 16) & 1u)) >> 16); }

constexpr int D = 1024, NB = 2, L = 8192, T = NB * L, CTX = 256, TC = NB * CTX, TT = T + TC;
constexpr int INW = 8224;
constexpr float EPS = 1e-6f;
constexpr size_t MiB = 1u << 20;
constexpr int NTHR = 512;
constexpr size_t WS_CTL = 0;
constexpr size_t WS_ADA = 1 * MiB;
constexpr size_t WS_ROPE = 1 * MiB + 256 * 1024;
constexpr size_t WS_LR = 2 * MiB;
constexpr size_t WS_ROUTE = 5 * MiB;
constexpr size_t WS_SORT = 6 * MiB;
constexpr size_t WS_WINM = 7 * MiB;
constexpr size_t WS_WBG = 11 * MiB, WS_WBR = 13 * MiB, WS_WOUT = 15 * MiB;
constexpr size_t WS_ST = 17 * MiB;
constexpr size_t WS_GQ = 52 * MiB;
constexpr size_t WS_GK = 68 * MiB;
constexpr size_t WS_RQ = 85 * MiB;
constexpr size_t WS_RK = 101 * MiB;
constexpr size_t WS_GV = 118 * MiB;
constexpr size_t WS_RV = 151 * MiB;
constexpr size_t WS_GG = 184 * MiB;
constexpr size_t WS_RG = 216 * MiB;
constexpr size_t WS_END = 248 * MiB;
constexpr size_t WS_EXPW = 52 * MiB;
constexpr size_t WS_Y = 100 * MiB, WS_S2 = 132 * MiB;
constexpr size_t WS_YS = 100 * MiB;
constexpr size_t DO_HL = 16 * MiB;
constexpr int CW_CNT = 1024;
constexpr int CW_CUR = 1024 + 64;
constexpr int CW_BAR = 4096;
constexpr int LDS_BYTES = 147456;
constexpr int LDS_MISC = LDS_BYTES - 256;

#define XB_TMO      128
#define XB_XCNT(j)  (256  + 64 * (j))
#define XB_XSUB(j)  (1280 + 64 * (j))
#define XB_XGEN(j)  (2304 + 64 * (j))
#define XB_TOP      3328
#define XB_TOPGEN   3392
#define XCD_BAR_WORDS 3456
#define XB_SPIN_CAP (1u << 18)
#define LAS __attribute__((address_space(3)))

__device__ __forceinline__ unsigned xb_ld(unsigned* p)              { return __hip_atomic_load(p, __ATOMIC_RELAXED, __HIP_MEMORY_SCOPE_AGENT); }
__device__ __forceinline__ unsigned xb_add(unsigned* p, unsigned v) { return __hip_atomic_fetch_add(p, v, __ATOMIC_RELAXED, __HIP_MEMORY_SCOPE_AGENT); }
__device__ __forceinline__ unsigned xb_xcc_id() { return (unsigned)__builtin_amdgcn_s_getreg((3 << 11) | 20) & 0xFu; }
#define XB_SPIN(cond, bar) do { unsigned _sp = 0; while (cond) { __builtin_amdgcn_s_sleep(1); \
    if ((++_sp & 255u) == 0u) { if (xb_ld(&(bar)[XB_TMO])) break; if (_sp > XB_SPIN_CAP) { atomicAdd(&(bar)[XB_TMO], 1u); break; } } } } while (0)

struct XcdBarrier {
    unsigned* bar; unsigned x;
    volatile LAS unsigned* st;
};

__device__ __forceinline__ XcdBarrier xcd_barrier_post(unsigned* bar, volatile LAS unsigned* st) {
    XcdBarrier b; b.bar = bar; b.x = xb_xcc_id(); b.st = st;
    if (threadIdx.x == 0) (void)xb_add(&bar[XB_XCNT(b.x)], 1u);
    return b;
}
__device__ __forceinline__ void xcd_barrier_complete(unsigned* bar, unsigned x, unsigned& nloc, unsigned& nx) {
    const unsigned G = gridDim.x * gridDim.y * gridDim.z;
    unsigned sum, cnt, mine, sp = 0u;
    for (;;) {
        sum = 0u; cnt = 0u; mine = 0u;
#pragma unroll
        for (unsigned j = 0; j < 16; ++j) { const unsigned c = xb_ld(&bar[XB_XCNT(j)]); sum += c; cnt += (c > 0u) ? 1u : 0u; mine = (j == x) ? c : mine; }
        if (sum == G) break;
        __builtin_amdgcn_s_sleep(1);
        if ((++sp & 255u) == 0u) { if (xb_ld(&bar[XB_TMO])) break; if (sp > XB_SPIN_CAP) { atomicAdd(&bar[XB_TMO], 1u); break; } }
    }
    nloc = mine > 0u ? mine : 1u; nx = cnt > 0u ? cnt : 1u;
}

__device__ __forceinline__ void xcd_barrier(const XcdBarrier& b) {
    asm volatile("s_waitcnt vmcnt(0)" ::: "memory");
    __syncthreads();
    if (threadIdx.x == 0) {
        unsigned* bar = b.bar;
        __builtin_amdgcn_s_waitcnt(0);
        unsigned nloc = b.st[0], nx = b.st[1];
        if (nloc == 0u) { xcd_barrier_complete(bar, b.x, nloc, nx); b.st[0] = nloc; b.st[1] = nx; }
        const unsigned old = xb_add(&bar[XB_XSUB(b.x)], 1u);
        const unsigned gen = old / nloc;
        if (old + 1u == (gen + 1u) * nloc) {
            __builtin_amdgcn_fence(__ATOMIC_RELEASE, "agent");
            asm volatile("s_waitcnt vmcnt(0)" ::: "memory");
            const unsigned og = xb_add(&bar[XB_TOP], 1u);
            const unsigned tg = og / nx;
            if (og + 1u == (tg + 1u) * nx) xb_add(&bar[XB_TOPGEN], 1u);
            else XB_SPIN(xb_ld(&bar[XB_TOPGEN]) == tg, bar);
            __builtin_amdgcn_fence(__ATOMIC_ACQUIRE, "agent");
            xb_add(&bar[XB_XGEN(b.x)], 1u);
            asm volatile("s_waitcnt vmcnt(0)" ::: "memory");
        } else {
            XB_SPIN(xb_ld(&bar[XB_XGEN(b.x)]) == gen, bar);
            __builtin_amdgcn_fence(__ATOMIC_ACQUIRE, "agent");
            asm volatile("s_waitcnt vmcnt(0)" ::: "memory");
        }
    }
    __syncthreads();
}
namespace pg8 {
#define PG8_LAS __attribute__((address_space(3)))
typedef unsigned short bf16_t;
typedef short bf16x8 __attribute__((ext_vector_type(8)));
typedef float f32x4 __attribute__((ext_vector_type(4)));
typedef unsigned u32x4 __attribute__((ext_vector_type(4)));
constexpr int BM = 256, BK = 64, HALF = 128, HTB = HALF * BK * 2  , STAGE_BYTES = 8 * HTB, NXCD = 8, WGM = 8;

__host__ __device__ __forceinline__ int lds_byte(int r, int c) { const int st = (r >> 4) * 2 + (c >> 5), rr = r & 15, cc = c & 31, ob = rr * 64 + cc * 2; return st * 1024 + (ob ^ (((ob >> 9) & 1) << 5)); }
__host__ __device__ __forceinline__ void stage_rc(int b, int& R, int& C) { const int st = b / 1024, sb = b % 1024, swz = sb ^ (((sb >> 9) & 1) << 5); R = (st >> 1) * 16 + swz / 64; C = (st & 1) * 32 + (swz % 64) / 2; }
__host__ __device__ __forceinline__ int perm32(int rho) { const int n = rho >> 4, i = rho & 15; return 8 * (i >> 2) + 4 * n + (i & 3); }

struct Unit { int pm, pn, k; };
struct Gemm { const bf16_t* A; const bf16_t* Bt; int M, N, K; };

struct StaticOrder {
    int nM, nN, nwg, G, c;
    __host__ __device__ void init(int M, int N, int G_, int c_) { nM = M / BM; nN = N / BM; nwg = nM * nN; G = G_; c = c_; }
    __host__ __device__ bool next(int i, Unit& u) const {
        const long L = (long)i * G + c; if (L >= nwg) return false;
        int wgid = (int)L; { const int q = nwg / NXCD, r = nwg % NXCD, xcd = wgid % NXCD, off = wgid / NXCD; wgid = (xcd < r ? xcd * (q + 1) : r * (q + 1) + (xcd - r) * q) + off; }
        const int nig = WGM * nN, gid = wgid / nig, fm = gid * WGM, gsz = (nM - fm) < WGM ? (nM - fm) : WGM;
        u.pm = fm + ((wgid % nig) % gsz); u.pn = (wgid % nig) / gsz; u.k = 0; return true;
    }
    __device__ __forceinline__ void a_ready(const Unit&) const {}
    __device__ __forceinline__ void done(const Unit&) const {}
    __device__ __forceinline__ const bf16_t* a_base(const Gemm& g, const Unit&) const { return g.A; }
    __device__ __forceinline__ const bf16_t* b_base(const Gemm& g, const Unit&) const { return g.Bt; }
};

__device__ __forceinline__ unsigned cvt_pk_bf16(float lo, float hi) { unsigned r; asm volatile("v_cvt_pk_bf16_f32 %0, %1, %2" : "=v"(r) : "v"(lo), "v"(hi)); return r; }
template <class Epi, class Sched, bool ALIGN_EPI = false, bool SP2 = false>
__device__ __forceinline__ void gemm_phase(PG8_LAS unsigned char* lds, const Gemm g, const Sched& S, const Epi& E) {
    int tid_ = threadIdx.x; asm volatile("" : "+v"(tid_));
    const int tid = tid_, wid = __builtin_amdgcn_readfirstlane(tid >> 6), lane = tid & 63, wr = wid >> 2, wc = wid & 3, fr = lane & 15, fq = lane >> 4;
    const int K = g.K, nt = K / BK;
    unsigned voffA[2], voffB[2];
#pragma unroll
    for (int i = 0; i < 2; ++i) { int R, C; stage_rc(tid * 16 + i * 8192, R, C); const int Rb = Epi::PERM ? ((R & ~31) + perm32(R & 31)) : R;
        voffA[i] = (unsigned)(R * K + C) * 2u; voffB[i] = (unsigned)(Rb * K + C) * 2u; }
    const size_t kstep = (size_t)(BK * 2);
    const size_t hstep = (size_t)HALF * K * 2;
    const size_t tstep = 2 * hstep;
    const unsigned ldsw = (unsigned)wid * 1024u;
    const int aoff = lds_byte(wr * 64 + fr, fq * 8), boff = lds_byte(wc * 32 + fr, fq * 8);
#define PG8_SA(b, h) (((b) * 2 + (h)) * HTB)
#define PG8_SB(b, h) ((4 + (b) * 2 + (h)) * HTB)
#define PG8_STAGE(bufoff, gbase, voff) do { _Pragma("unroll") for (int _i = 0; _i < 2; ++_i) \
        __builtin_amdgcn_global_load_lds((const unsigned*)((const char*)(gbase) + (voff)[_i]), (PG8_LAS unsigned*)(lds + (bufoff) + ldsw + _i * 8192), 16, 0, 0); } while (0)
#define PG8_LDA(dst, b, h) do { _Pragma("unroll") for (int m = 0; m < 4; ++m) _Pragma("unroll") for (int k = 0; k < 2; ++k) dst[m][k] = *(const PG8_LAS bf16x8*)(lds + PG8_SA(b, h) + aoff + m * 2048 + k * 1024); } while (0)
#define PG8_LDB(dst, b, h) do { _Pragma("unroll") for (int n = 0; n < 2; ++n) _Pragma("unroll") for (int k = 0; k < 2; ++k) dst[n][k] = *(const PG8_LAS bf16x8*)(lds + PG8_SB(b, h) + boff + n * 2048 + k * 1024); } while (0)
#define PG8_MMA(ai, bj, At, Bt) do { __builtin_amdgcn_s_setprio(1); _Pragma("unroll") for (int m = 0; m < 4; ++m) _Pragma("unroll") for (int n = 0; n < 2; ++n) _Pragma("unroll") for (int k = 0; k < 2; ++k) \
        acc[ai][bj][m][n] = __builtin_amdgcn_mfma_f32_16x16x32_bf16(Bt[n][k], At[m][k], acc[ai][bj][m][n], 0, 0, 0); __builtin_amdgcn_s_setprio(0); } while (0)
#define PG8_WAIT_V(n) asm volatile("s_waitcnt vmcnt(" #n ")" ::: "memory")
#define PG8_WAIT_L(n) asm volatile("s_waitcnt lgkmcnt(" #n ")" ::: "memory")
#define PG8_BAR __builtin_amdgcn_s_barrier()
#define PG8_SCHED __builtin_amdgcn_sched_barrier(0)
    Unit cur, nxt; int ui = 0;
    if (!S.next(0, cur)) return;
    f32x4 acc[2][2][4][2];
#pragma unroll
    for (int a = 0; a < 2; ++a)
#pragma unroll
        for (int b = 0; b < 2; ++b)
#pragma unroll
            for (int m = 0; m < 4; ++m)
#pragma unroll
                for (int n = 0; n < 2; ++n) acc[a][b][m][n] = (f32x4){0.f, 0.f, 0.f, 0.f};
    bf16x8 At[4][2], B0[2][2], B1[2][2];
    const char* cA = (const char*)S.a_base(g, cur) + (size_t)cur.pm * tstep; const char* cB = (const char*)S.b_base(g, cur) + (size_t)cur.pn * tstep;
    S.a_ready(cur);
    if constexpr (SP2) {
        PG8_STAGE(PG8_SB(0, 0), cB, voffB); PG8_STAGE(PG8_SB(0, 1), cB + hstep, voffB); PG8_STAGE(PG8_SA(0, 0), cA, voffA); PG8_STAGE(PG8_SA(0, 1), cA + hstep, voffA);
        if (wr == 1) PG8_BAR;
        PG8_WAIT_V(2); PG8_BAR;
        PG8_STAGE(PG8_SB(1, 0), cB + kstep, voffB); PG8_STAGE(PG8_SA(1, 0), cA + kstep, voffA); PG8_STAGE(PG8_SB(1, 1), cB + hstep + kstep, voffB);
        PG8_WAIT_V(6); PG8_BAR;
    } else {
        PG8_STAGE(PG8_SB(0, 0), cB, voffB); PG8_STAGE(PG8_SA(0, 0), cA, voffA); PG8_STAGE(PG8_SB(0, 1), cB + hstep, voffB); PG8_STAGE(PG8_SA(0, 1), cA + hstep, voffA);
        if (wr == 1) PG8_BAR;
        PG8_WAIT_V(4); PG8_BAR;
        PG8_STAGE(PG8_SB(1, 0), cB + kstep, voffB); PG8_STAGE(PG8_SA(1, 0), cA + kstep, voffA); PG8_STAGE(PG8_SB(1, 1), cB + hstep + kstep, voffB);
        PG8_WAIT_V(6); PG8_BAR;
    }
    for (;;) {
        const bool has_next = S.next(ui + 1, nxt);
        const char* nA = has_next ? (const char*)S.a_base(g, nxt) + (size_t)nxt.pm * tstep : cA; const char* nB = has_next ? (const char*)S.b_base(g, nxt) + (size_t)nxt.pn * tstep : cB;
        for (int t = 0; t < nt; t += 2) {
            const bool last = (t == nt - 2);
            const char* a1 = cA + (size_t)(t + 1) * kstep;
            const char* a2 = last ? nA : cA + (size_t)(t + 2) * kstep; const char* b2 = last ? nB : cB + (size_t)(t + 2) * kstep;
            const char* a3 = a2 + kstep; const char* b3 = b2 + kstep;
            if (last && has_next) S.a_ready(nxt);
            if constexpr (SP2) {
            PG8_LDB(B0, 0, 0); PG8_LDB(B1, 0, 1); PG8_SCHED; PG8_LDA(At, 0, 0); PG8_STAGE(PG8_SA(1, 1), a1 + hstep, voffA);
            PG8_WAIT_V(8); PG8_WAIT_L(0); PG8_BAR; PG8_MMA(0, 0, At, B0); PG8_MMA(0, 1, At, B1); PG8_BAR; PG8_SCHED;
            PG8_LDA(At, 0, 1); PG8_STAGE(PG8_SB(0, 0), b2, voffB); PG8_STAGE(PG8_SB(0, 1), b2 + hstep, voffB); PG8_STAGE(PG8_SA(0, 0), a2, voffA);
            PG8_WAIT_V(8); PG8_WAIT_L(0); PG8_BAR; PG8_MMA(1, 0, At, B0); PG8_MMA(1, 1, At, B1); PG8_BAR; PG8_SCHED;
            PG8_LDB(B0, 1, 0); PG8_LDB(B1, 1, 1); PG8_SCHED; PG8_LDA(At, 1, 0); PG8_STAGE(PG8_SA(0, 1), a2 + hstep, voffA);
            PG8_WAIT_V(8); PG8_WAIT_L(0); PG8_BAR; PG8_MMA(0, 0, At, B0); PG8_MMA(0, 1, At, B1); PG8_BAR; PG8_SCHED;
            PG8_LDA(At, 1, 1); PG8_STAGE(PG8_SB(1, 0), b3, voffB); PG8_STAGE(PG8_SB(1, 1), b3 + hstep, voffB); PG8_STAGE(PG8_SA(1, 0), a3, voffA);
            PG8_WAIT_V(8); PG8_WAIT_L(0); PG8_BAR; PG8_MMA(1, 0, At, B0); PG8_MMA(1, 1, At, B1); PG8_BAR; PG8_SCHED;
            } else {
            PG8_LDB(B0, 0, 0); PG8_SCHED; PG8_LDA(At, 0, 0); PG8_STAGE(PG8_SA(1, 1), a1 + hstep, voffA);
            PG8_WAIT_L(8); PG8_BAR; PG8_WAIT_L(0); PG8_MMA(0, 0, At, B0); PG8_BAR; PG8_SCHED;
            PG8_LDB(B1, 0, 1); PG8_STAGE(PG8_SB(0, 0), b2, voffB);
            PG8_BAR; PG8_WAIT_L(0); PG8_MMA(0, 1, At, B1); PG8_BAR;
            PG8_LDA(At, 0, 1); PG8_STAGE(PG8_SA(0, 0), a2, voffA);
            PG8_BAR; PG8_WAIT_L(0); PG8_MMA(1, 0, At, B0); PG8_BAR; PG8_SCHED;
            PG8_STAGE(PG8_SB(0, 1), b2 + hstep, voffB);
            PG8_WAIT_V(6); PG8_BAR; PG8_MMA(1, 1, At, B1); PG8_BAR;
            PG8_LDB(B0, 1, 0); PG8_SCHED; PG8_LDA(At, 1, 0); PG8_STAGE(PG8_SA(0, 1), a2 + hstep, voffA);
            PG8_WAIT_L(8); PG8_BAR; PG8_WAIT_L(0); PG8_MMA(0, 0, At, B0); PG8_BAR; PG8_SCHED;
            PG8_LDB(B1, 1, 1); PG8_STAGE(PG8_SB(1, 0), b3, voffB);
            PG8_BAR; PG8_WAIT_L(0); PG8_MMA(0, 1, At, B1); PG8_BAR;
            PG8_LDA(At, 1, 1); PG8_STAGE(PG8_SA(1, 0), a3, voffA);
            PG8_BAR; PG8_WAIT_L(0); PG8_MMA(1, 0, At, B0); PG8_BAR; PG8_SCHED;
            PG8_STAGE(PG8_SB(1, 1), b3 + hstep, voffB);
            PG8_WAIT_V(6); PG8_BAR; PG8_MMA(1, 1, At, B1); PG8_BAR;
            }
        }
        if constexpr (ALIGN_EPI) { if (wr == 0) PG8_BAR; }
        if constexpr (!Epi::AFTER_DRAIN) { E(acc, cur, wr, wc, fr, fq); S.done(cur); }
        if (!has_next) break;
#pragma unroll
        for (int a = 0; a < 2; ++a)
#pragma unroll
            for (int b = 0; b < 2; ++b)
#pragma unroll
                for (int m = 0; m < 4; ++m)
#pragma unroll
                    for (int n = 0; n < 2; ++n) acc[a][b][m][n] = (f32x4){0.f, 0.f, 0.f, 0.f};
        cur = nxt; cA = nA; cB = nB; ++ui;
        if constexpr (ALIGN_EPI) { if (wr == 1) PG8_BAR; }
    }
    PG8_WAIT_V(0);
    if constexpr (!ALIGN_EPI) { if (wr == 0) PG8_BAR; }
    PG8_BAR;
    if constexpr (Epi::AFTER_DRAIN) { E.fused(acc, cur, wr, wc, fr, fq, lds, wid, lane); S.done(cur); }
#undef PG8_SA
#undef PG8_SB
#undef PG8_STAGE
#undef PG8_LDA
#undef PG8_LDB
#undef PG8_MMA
#undef PG8_WAIT_V
#undef PG8_WAIT_L
#undef PG8_BAR
#undef PG8_SCHED
}
}
#define LDSF(off) ((LAS float*)(lds + (off)))
__device__ __forceinline__ float silu_f(float x) { return x / (1.f + expf(-x)); }

__device__ __forceinline__ void p_ada(LAS unsigned char* lds, const float* c, const float* cctx, const float* w_ada, const float* b_ada, float* ada, float2* rope) {
    int tidx_ = threadIdx.x; asm volatile("" : "+v"(tidx_));
    const int tid = tidx_;
    LAS float* sil = LDSF(0);
    LAS float* red = LDSF(12288);
    for (int i = tid; i < 3072; i += NTHR) { const int r = i >> 10, k = i & 1023; const float x = r < 2 ? c[r * 1024 + k] : cctx[k]; sil[i] = silu_f(x); }
    __syncthreads();
    const int cj = tid & 31, kq = tid >> 5;
    for (int cb = blockIdx.x; cb < 256; cb += gridDim.x) {
        float a0 = 0.f, a1 = 0.f, a2 = 0.f;
        if (cj < 24) { const float* wp = w_ada + (size_t)(kq * 64) * 6144 + cb * 24 + cj;
#pragma unroll 8
            for (int k = 0; k < 64; ++k) { const float w = wp[(size_t)k * 6144]; a0 += sil[kq * 64 + k] * w; a1 += sil[1024 + kq * 64 + k] * w; a2 += sil[2048 + kq * 64 + k] * w; } }
        red[(kq * 3 + 0) * 32 + cj] = a0; red[(kq * 3 + 1) * 32 + cj] = a1; red[(kq * 3 + 2) * 32 + cj] = a2;
        __syncthreads();
        if (tid < 96) { const int r = tid >> 5, j = tid & 31; if (j < 24) { float s = 0.f; for (int q = 0; q < 16; ++q) s += red[(q * 3 + r) * 32 + j]; const int n = cb * 24 + j; ada[r * 6144 + n] = s + b_ada[n]; } }
        __syncthreads();
    }
    for (int idx = blockIdx.x * NTHR + tid; idx < 128 * 32; idx += gridDim.x * NTHR) {
        const int p = idx / 32, j = idx % 32; const float inv = powf(10000.f, -(float)j / 32.f); const float ang = (float)p * inv;
        rope[idx] = make_float2(cosf(ang), sinf(ang)); }
}
__device__ __forceinline__ void p_norm_mod(const float* x, const float* ctx, const float* gnorm, const float* ada, bf16* hl, int row_lo, int row_hi) {
    int tidx_ = threadIdx.x; asm volatile("" : "+v"(tidx_));
    const int lane = tidx_ & 63, gw = blockIdx.x * (NTHR / 64) + (tidx_ >> 6), ngw = gridDim.x * (NTHR / 64);
    for (int r = row_lo + gw; r < row_hi; r += ngw) {
        const float* src = r < T ? x + (size_t)r * D : ctx + (size_t)(r - T) * D;
        const int ar = r < T ? r / L : 2;
        const float* sh = ada + ar * 6144; const float* sc = sh + 1024;
        float4 v[4]; float ss = 0.f;
#pragma unroll
        for (int j = 0; j < 4; ++j) { v[j] = *(const float4*)(src + j * 256 + lane * 4); ss += v[j].x * v[j].x + v[j].y * v[j].y + v[j].z * v[j].z + v[j].w * v[j].w; }
#pragma unroll
        for (int o = 1; o < 64; o <<= 1) ss += __shfl_xor(ss, o);
        const float rstd = rsqrtf(ss * (1.f / D) + EPS);
#pragma unroll
        for (int j = 0; j < 4; ++j) { const int c = j * 256 + lane * 4;
            const float4 g = *(const float4*)(gnorm + c), s1 = *(const float4*)(sc + c), s0 = *(const float4*)(sh + c);
            const float y0 = v[j].x * rstd * g.x * (1.f + s1.x) + s0.x, y1 = v[j].y * rstd * g.y * (1.f + s1.y) + s0.y, y2 = v[j].z * rstd * g.z * (1.f + s1.z) + s0.z, y3 = v[j].w * rstd * g.w * (1.f + s1.w) + s0.w;
            uint2 o2; o2.x = (unsigned)f2bf(y0) | ((unsigned)f2bf(y1) << 16); o2.y = (unsigned)f2bf(y2) | ((unsigned)f2bf(y3) << 16);
            *(uint2*)(hl + (size_t)r * D + c) = o2; }
    }
}
template <class Epi> __device__ __forceinline__ void p_gemm_naive(LAS unsigned char* lds, const bf16* A, int lda, const float* W, int ldw, int M, int N, int K, const Epi& epi) {
    LAS float* As = LDSF(0);
    LAS float* Ws = LDSF(16 * 132 * 4);
    const int tid = threadIdx.x, tx = tid & 31, ty = tid >> 5;
    const int nbn = (N + 127) / 128, nblk = nbn * (M / 128);
    for (int vb = blockIdx.x; vb < nblk; vb += gridDim.x) {
        const int bm = (vb / nbn) * 128, bn = (vb % nbn) * 128;
        float acc[8][4];
#pragma unroll
        for (int i = 0; i < 8; ++i)
#pragma unroll
            for (int j = 0; j < 4; ++j) acc[i][j] = 0.f;
        for (int k0 = 0; k0 < K; k0 += 16) {
            if (tid < 256) { const int r = tid >> 1, kk = (tid & 1) * 8; const bf16* ap = A + (size_t)(bm + r) * lda + k0 + kk;
                const uint4 raw = *(const uint4*)ap; const unsigned w[4] = {raw.x, raw.y, raw.z, raw.w};
#pragma unroll
                for (int i = 0; i < 4; ++i) { As[(kk + 2 * i) * 132 + r] = __uint_as_float(w[i] << 16); As[(kk + 2 * i + 1) * 132 + r] = __uint_as_float(w[i] & 0xffff0000u); } }
            { const int kk = tid >> 5, n = (tid & 31) * 4; const float* wp = W + (size_t)(k0 + kk) * ldw + bn + n;
#pragma unroll
              for (int i = 0; i < 4; ++i) Ws[kk * 132 + n + i] = (bn + n + i < N) ? wp[i] : 0.f; }
            __syncthreads();
#pragma unroll
            for (int kk = 0; kk < 16; ++kk) {
                float a[8], w[4];
#pragma unroll
                for (int i = 0; i < 8; ++i) a[i] = As[kk * 132 + ty * 8 + i];
#pragma unroll
                for (int j = 0; j < 4; ++j) w[j] = Ws[kk * 132 + tx * 4 + j];
#pragma unroll
                for (int i = 0; i < 8; ++i)
#pragma unroll
                    for (int j = 0; j < 4; ++j) acc[i][j] += a[i] * w[j];
            }
            __syncthreads();
        }
#pragma unroll
        for (int i = 0; i < 8; ++i)
#pragma unroll
            for (int j = 0; j < 4; ++j) { const int r = bm + ty * 8 + i, c = bn + tx * 4 + j; if (c < N) epi(r, c, acc[i][j]); }
    }
}
struct EpiProj {
    bf16 *GQ, *GK, *GV, *GG, *RQ, *RK, *RV, *RG; float* LR;
    __device__ __forceinline__ void operator()(int r, int c, float v) const {
        const float s = 0.08838834764831845f;
        if (c < 512) { if (r < T) GQ[(size_t)r * 512 + c] = f2bf(v * s); }
        else if (c < 1024) GK[(size_t)r * 512 + c - 512] = f2bf(v);
        else if (c < 2048) GV[(size_t)r * 1024 + c - 1024] = f2bf(v);
        else if (c < 3072) { if (r < T) GG[(size_t)r * 1024 + c - 2048] = f2bf(v); }
        else if (c < 3104) LR[(size_t)r * 32 + c - 3072] = v;
        else if (c < 3616) { if (r < T) RQ[(size_t)r * 512 + c - 3104] = f2bf(v); }
        else if (c < 4128) RK[(size_t)r * 512 + c - 3616] = f2bf(v * s);
        else if (c < 5152) RV[(size_t)r * 1024 + c - 4128] = f2bf(v);
        else { if (r < T) RG[(size_t)r * 1024 + c - 5152] = f2bf(v); }
    }
};
struct EpiSig { bf16* S; __device__ __forceinline__ void operator()(int r, int c, float v) const { S[(size_t)r * 1024 + c] = f2bf(1.f / (1.f + expf(-v))); } };
struct EpiGate1 { bf16* Y; __device__ __forceinline__ void operator()(int r, int c, float v) const { const size_t i = (size_t)r * 1024 + c; Y[i] = f2bf(bf2f(Y[i]) * v); } };
struct EpiGate2 { bf16* Y; const bf16* S2; __device__ __forceinline__ void operator()(int r, int c, float v) const { const size_t i = (size_t)r * 1024 + c; Y[i] = f2bf(bf2f(Y[i]) + bf2f(S2[i]) * v); } };
struct EpiOut { const float* x; const float* ada; float* H1; __device__ __forceinline__ void operator()(int r, int c, float v) const { const size_t i = (size_t)r * 1024 + c; H1[i] = x[i] + ada[(r / L) * 6144 + 2048 + c] * v; } };

__device__ __forceinline__ void p_rope(bf16* RQ, bf16* RK, const float2* tab) {
    for (size_t idx = (size_t)blockIdx.x * NTHR + threadIdx.x; idx < (size_t)T * 256; idx += (size_t)gridDim.x * NTHR) {
        const int j = idx & 31, half = (idx >> 5) & 1, h = (idx >> 6) & 3; const int r = (int)(idx >> 8);
        const int l = r % L; const int pos = half == 0 ? l / 64 : l % 64;
        const float2 cs = tab[pos * 32 + j];
        const size_t o = (size_t)r * 512 + h * 128 + half * 64 + j;
        { const float u1 = bf2f(RQ[o]), u2 = bf2f(RQ[o + 32]); RQ[o] = f2bf(u1 * cs.x - u2 * cs.y); RQ[o + 32] = f2bf(u1 * cs.y + u2 * cs.x); }
        { const float u1 = bf2f(RK[o]), u2 = bf2f(RK[o + 32]); RK[o] = f2bf(u1 * cs.x - u2 * cs.y); RK[o + 32] = f2bf(u1 * cs.y + u2 * cs.x); }
    }
}
struct ScanP { const bf16 *GQ, *GK, *GV, *RQ, *RK, *RV; bf16 *GG, *RG; const float *LR, *lrw, *lrb, *gnorm; bf16* OF; };
template <int DIR> __device__ __forceinline__ void p_scan_naive(LAS unsigned char* lds, const ScanP& p) {
    const int t = threadIdx.x, w = t >> 6, l = t & 63;
    LAS float* sq = LDSF(0); LAS float* sk = LDSF(512); LAS float* sa = LDSF(1024); LAS float* sv = LDSF(1536); LAS float* red = LDSF(2560); LAS float* rs = LDSF(2560 + 8192);
    for (int unit = blockIdx.x; unit < 16; unit += gridDim.x) {
        const int mixer = unit >> 3, b = (unit >> 2) & 1, h = unit & 3;
        const bf16* Q = mixer ? p.RQ : p.GQ; const bf16* K = mixer ? p.RK : p.GK; const bf16* V = mixer ? p.RV : p.GV; bf16* G = mixer ? p.RG : p.GG;
        float S[16][4];
#pragma unroll
        for (int i = 0; i < 16; ++i)
#pragma unroll
            for (int j = 0; j < 4; ++j) S[i][j] = 0.f;
        const float gamma = 1.f - exp2f(-(DIR ? 5.5f : 5.0f) - (float)h);
        for (int step = 0; step < CTX + L; ++step) {
            const bool isctx = step < CTX; const int idx = isctx ? step : step - CTX;
            const int tok = DIR == 0 ? idx : (isctx ? CTX - 1 - idx : L - 1 - idx);
            const size_t rkv = isctx ? (size_t)T + b * CTX + tok : (size_t)b * L + tok;
            const size_t rq = (size_t)b * L + tok;
            if (t < 128) {
                sk[t] = bf2f(K[rkv * 512 + h * 128 + t]);
                sq[t] = isctx ? 0.f : bf2f(Q[rq * 512 + h * 128 + t]);
                if (mixer == 0) {
                    float z = p.lrb[DIR * 512 + h * 128 + t];
                    for (int r = 0; r < 16; ++r) z += p.LR[rkv * 32 + DIR * 16 + r] * p.lrw[(DIR * 16 + r) * 512 + h * 128 + t];
                    const float ls = fminf(z, 0.f) - log1pf(expf(-fabsf(z)));
                    sa[t] = expf(ls * (1.f / 16.f));
                } else sa[t] = gamma;
            } else if (t < 384) sv[t - 128] = bf2f(V[rkv * 1024 + h * 256 + t - 128]);
            __syncthreads();
            float o[4] = {0.f, 0.f, 0.f, 0.f}; const float v[4] = {sv[4 * l], sv[4 * l + 1], sv[4 * l + 2], sv[4 * l + 3]};
#pragma unroll
            for (int i = 0; i < 16; ++i) { const int dk = 16 * w + i; const float a = sa[dk], kk = sk[dk], qq = sq[dk];
#pragma unroll
                for (int j = 0; j < 4; ++j) {
                    if (DIR == 0) { S[i][j] = a * S[i][j] + kk * v[j]; o[j] += qq * S[i][j]; }
                    else { const float sp = a * S[i][j]; o[j] += qq * sp; S[i][j] = sp + kk * v[j]; } } }
            if (!isctx) {
#pragma unroll
                for (int j = 0; j < 4; ++j) red[w * 256 + 4 * l + j] = o[j];
                __syncthreads();
                float ot = 0.f;
                if (t < 256) { for (int i = 0; i < 8; ++i) ot += red[i * 256 + t]; }
                if (DIR == 0) { if (t < 256) p.OF[rq * 2048 + mixer * 1024 + h * 256 + t] = f2bf(ot); }
                else {
                    if (t < 256) ot += bf2f(p.OF[rq * 2048 + mixer * 1024 + h * 256 + t]);
                    float s1 = t < 256 ? ot : 0.f;
#pragma unroll
                    for (int o2 = 1; o2 < 64; o2 <<= 1) s1 += __shfl_xor(s1, o2);
                    if (l == 0) rs[w] = s1; __syncthreads();
                    const float mu = (rs[0] + rs[1] + rs[2] + rs[3]) * (1.f / 256.f); __syncthreads();
                    const float dv = mixer ? ot - mu : ot;
                    float s2 = t < 256 ? dv * dv : 0.f;
#pragma unroll
                    for (int o2 = 1; o2 < 64; o2 <<= 1) s2 += __shfl_xor(s2, o2);
                    if (l == 0) rs[w] = s2; __syncthreads();
                    const float var = (rs[0] + rs[1] + rs[2] + rs[3]) * (1.f / 256.f);
                    if (t < 256) { float y = dv * rsqrtf(var + EPS); if (mixer == 0) y *= p.gnorm[t];
                        const size_t gi = rq * 1024 + h * 256 + t; const float g = bf2f(G[gi]); y *= silu_f(g); G[gi] = f2bf(y); }
                }
            }
            __syncthreads();
        }
    }
}
struct RouteP { const float *H1, *gnorm, *ada, *wrg, *brg, *wre, *bre; bf16* H2; int4* route; float2* rw; unsigned* cnt; };
__device__ __forceinline__ void p_norm_route(const RouteP& p) {
    const int lane = threadIdx.x & 63, gw = blockIdx.x * (NTHR / 64) + (threadIdx.x >> 6), ngw = gridDim.x * (NTHR / 64);
    for (int r = gw; r < T; r += ngw) {
        const float* src = p.H1 + (size_t)r * D; const float* sh = p.ada + (r / L) * 6144 + 3072; const float* sc = sh + 1024;
        float4 v[4]; float ss = 0.f;
#pragma unroll
        for (int j = 0; j < 4; ++j) { v[j] = *(const float4*)(src + j * 256 + lane * 4); ss += v[j].x * v[j].x + v[j].y * v[j].y + v[j].z * v[j].z + v[j].w * v[j].w; }
#pragma unroll
        for (int o = 1; o < 64; o <<= 1) ss += __shfl_xor(ss, o);
        const float rstd = rsqrtf(ss * (1.f / D) + EPS);
        float gl[4] = {0.f, 0.f, 0.f, 0.f};
#pragma unroll
        for (int j = 0; j < 4; ++j) { const int c = j * 256 + lane * 4;
            const float4 g = *(const float4*)(p.gnorm + c), s1 = *(const float4*)(sc + c), s0 = *(const float4*)(sh + c);
            v[j].x = v[j].x * rstd * g.x * (1.f + s1.x) + s0.x; v[j].y = v[j].y * rstd * g.y * (1.f + s1.y) + s0.y; v[j].z = v[j].z * rstd * g.z * (1.f + s1.z) + s0.z; v[j].w = v[j].w * rstd * g.w * (1.f + s1.w) + s0.w;
            uint2 o2; o2.x = (unsigned)f2bf(v[j].x) | ((unsigned)f2bf(v[j].y) << 16); o2.y = (unsigned)f2bf(v[j].z) | ((unsigned)f2bf(v[j].w) << 16);
            *(uint2*)(p.H2 + (size_t)r * D + c) = o2;
            const float yy[4] = {v[j].x, v[j].y, v[j].z, v[j].w};
#pragma unroll
            for (int i = 0; i < 4; ++i) { const float4 wv = *(const float4*)(p.wrg + (size_t)(c + i) * 4); gl[0] += yy[i] * wv.x; gl[1] += yy[i] * wv.y; gl[2] += yy[i] * wv.z; gl[3] += yy[i] * wv.w; } }
#pragma unroll
        for (int g = 0; g < 4; ++g) { float s = gl[g];
#pragma unroll
            for (int o = 1; o < 64; o <<= 1) s += __shfl_xor(s, o); gl[g] = s + p.brg[g]; }
        int gs = 0; float gmax = gl[0];
#pragma unroll
        for (int g = 1; g < 4; ++g) if (gl[g] > gmax) { gmax = gl[g]; gs = g; }
        float den = 0.f;
#pragma unroll
        for (int g = 0; g < 4; ++g) den += expf(gl[g] - gmax);
        const float gwt = 1.f / den;
        float el[8];
#pragma unroll
        for (int e = 0; e < 8; ++e) el[e] = 0.f;
#pragma unroll
        for (int j = 0; j < 4; ++j) { const int c = j * 256 + lane * 4; const float yy[4] = {v[j].x, v[j].y, v[j].z, v[j].w};
#pragma unroll
            for (int i = 0; i < 4; ++i) { const float* wp = p.wre + (size_t)(c + i) * 32 + gs * 8; const float4 w0 = *(const float4*)wp, w1 = *(const float4*)(wp + 4);
                el[0] += yy[i] * w0.x; el[1] += yy[i] * w0.y; el[2] += yy[i] * w0.z; el[3] += yy[i] * w0.w; el[4] += yy[i] * w1.x; el[5] += yy[i] * w1.y; el[6] += yy[i] * w1.z; el[7] += yy[i] * w1.w; } }
#pragma unroll
        for (int e = 0; e < 8; ++e) { float s = el[e];
#pragma unroll
            for (int o = 1; o < 64; o <<= 1) s += __shfl_xor(s, o); el[e] = s + p.bre[gs * 8 + e]; }
        int i0 = 0; float v0 = el[0];
#pragma unroll
        for (int e = 1; e < 8; ++e) if (el[e] > v0) { v0 = el[e]; i0 = e; }
        int i1 = -1; float v1 = -3.0e38f;
#pragma unroll
        for (int e = 0; e < 8; ++e) if (e != i0 && el[e] > v1) { v1 = el[e]; i1 = e; }
        if (lane == 0) {
            const float w0 = 1.f / (1.f + expf(v1 - v0)), w1 = 1.f - w0;
            const int e0 = gs * 8 + i0, e1 = gs * 8 + i1;
            p.route[r] = make_int4(e0, e1, 0, 0); p.rw[r] = make_float2(w0 * gwt, w1 * gwt);
            atomicAdd(&p.cnt[e0], 1u); atomicAdd(&p.cnt[e1], 1u);
        }
    }
}
constexpr int MB = 8;
__device__ __forceinline__ void p_dispatch(LAS unsigned char* lds, int4* route, const unsigned* cnt, unsigned* cur, int* sorted) {
    LAS unsigned* off = (LAS unsigned*)lds;
    if (threadIdx.x == 0) { unsigned o = 0; for (int e = 0; e < 32; ++e) { off[e] = o; o += (cnt[e] + MB - 1) / MB * MB; } off[32] = o; }
    __syncthreads();
    for (int r = blockIdx.x * NTHR + threadIdx.x; r < T; r += gridDim.x * NTHR) {
        int4 rt = route[r];
        const unsigned s0 = off[rt.x] + atomicAdd(&cur[rt.x], 1u), s1 = off[rt.y] + atomicAdd(&cur[rt.y], 1u);
        sorted[s0] = r; sorted[s1] = r; rt.z = (int)s0; rt.w = (int)s1; route[r] = rt;
    }
    __syncthreads();
}
__device__ __forceinline__ void p_expert_naive(LAS unsigned char* lds, const bf16* H2, const int* sorted, const unsigned* cnt, const float* wg, const float* wu, const float* wd, float* YS) {
    LAS float* xs = LDSF(0);
    LAS float* hs = LDSF(MB * 4096);
    LAS unsigned* off = (LAS unsigned*)(lds + MB * 4096 + MB * 1024);
    LAS int* toks = (LAS int*)(lds + MB * 4096 + MB * 1024 + 256);
    const int t = threadIdx.x;
    if (t == 0) { unsigned o = 0; for (int e = 0; e < 32; ++e) { off[e] = o; o += (cnt[e] + MB - 1) / MB * MB; } off[32] = o; }
    __syncthreads();
    const int nblk = (int)(off[32] / MB);
    for (int vb = blockIdx.x; vb < nblk; vb += gridDim.x) {
        const unsigned s0 = vb * MB;
        int e = 0; while (off[e + 1] <= s0) ++e;
        const unsigned rem = cnt[e] - (s0 - off[e]); const unsigned nreal = rem > (unsigned)MB ? (unsigned)MB : rem;
        __syncthreads();
        if (t < MB) toks[t] = t < (int)nreal ? sorted[s0 + t] : -1;
        __syncthreads();
        for (int i = t; i < MB * 1024; i += NTHR) { const int m = i >> 10, c = i & 1023; xs[i] = toks[m] >= 0 ? bf2f(H2[(size_t)toks[m] * D + c]) : 0.f; }
        __syncthreads();
        { const int j = t & 255, hm = t >> 8;
          float ag[4], au[4];
#pragma unroll
          for (int i = 0; i < 4; ++i) { ag[i] = 0.f; au[i] = 0.f; }
          const float* pg = wg + (size_t)e * 1024 * 256 + j; const float* pu = wu + (size_t)e * 1024 * 256 + j;
          for (int k = 0; k < 1024; ++k) { const float g = pg[(size_t)k * 256], u = pu[(size_t)k * 256];
#pragma unroll
              for (int i = 0; i < 4; ++i) { const float x = xs[(hm * 4 + i) * 1024 + k]; ag[i] += x * g; au[i] += x * u; } }
#pragma unroll
          for (int i = 0; i < 4; ++i) hs[(hm * 4 + i) * 256 + j] = silu_f(ag[i]) * au[i]; }
        __syncthreads();
        { float acc[MB][2];
#pragma unroll
          for (int m = 0; m < MB; ++m) { acc[m][0] = 0.f; acc[m][1] = 0.f; }
          const float* pd = wd + (size_t)e * 256 * 1024;
          for (int j = 0; j < 256; ++j) { const float d0 = pd[(size_t)j * 1024 + t], d1 = pd[(size_t)j * 1024 + 512 + t];
#pragma unroll
              for (int m = 0; m < MB; ++m) { const float hv = hs[m * 256 + j]; acc[m][0] += hv * d0; acc[m][1] += hv * d1; } }
#pragma unroll
          for (int m = 0; m < MB; ++m) { YS[(size_t)(s0 + m) * 1024 + t] = acc[m][0]; YS[(size_t)(s0 + m) * 1024 + 512 + t] = acc[m][1]; } }
    }
    __syncthreads();
}
__device__ __forceinline__ void p_final(const float* H1, const float* YS, const int4* route, const float2* rw, const float* ada, const float* gfin, float* out) {
    int tidx_ = threadIdx.x; asm volatile("" : "+v"(tidx_));
    const int lane = tidx_ & 63, gw = blockIdx.x * (NTHR / 64) + (tidx_ >> 6), ngw = gridDim.x * (NTHR / 64);
    for (int r = gw; r < T; r += ngw) {
        const int4 rt = route[r]; const float2 w = rw[r]; const float* g2 = ada + (r / L) * 6144 + 5120;
        float4 v[4]; float ss = 0.f;
#pragma unroll
        for (int j = 0; j < 4; ++j) { const int c = j * 256 + lane * 4;
            const float4 y0 = *(const float4*)(YS + (size_t)rt.z * 1024 + c), y1 = *(const float4*)(YS + (size_t)rt.w * 1024 + c), hh = *(const float4*)(H1 + (size_t)r * D + c), g = *(const float4*)(g2 + c);
            v[j].x = hh.x + g.x * (w.x * y0.x + w.y * y1.x); v[j].y = hh.y + g.y * (w.x * y0.y + w.y * y1.y); v[j].z = hh.z + g.z * (w.x * y0.z + w.y * y1.z); v[j].w = hh.w + g.w * (w.x * y0.w + w.y * y1.w);
            ss += v[j].x * v[j].x + v[j].y * v[j].y + v[j].z * v[j].z + v[j].w * v[j].w; }
#pragma unroll
        for (int o = 1; o < 64; o <<= 1) ss += __shfl_xor(ss, o);
        const float rstd = rsqrtf(ss * (1.f / D) + EPS);
#pragma unroll
        for (int j = 0; j < 4; ++j) { const int c = j * 256 + lane * 4; const float4 g = *(const float4*)(gfin + c);
            float4 o4; o4.x = v[j].x * rstd * g.x; o4.y = v[j].y * rstd * g.y; o4.z = v[j].z * rstd * g.z; o4.w = v[j].w * rstd * g.w;
            *(float4*)(out + (size_t)r * D + c) = o4; }
    }
}
#define GAS __attribute__((address_space(1)))
typedef unsigned v4u __attribute__((ext_vector_type(4)));
typedef unsigned v2u __attribute__((ext_vector_type(2)));
typedef short bf16x8 __attribute__((ext_vector_type(8)));
typedef float f32x16 __attribute__((ext_vector_type(16)));
typedef float f32x4 __attribute__((ext_vector_type(4)));
#define LDS_WAIT() asm volatile("s_waitcnt lgkmcnt(0)" ::: "memory")
__device__ __forceinline__ unsigned pk2(float lo, float hi) { return pg8::cvt_pk_bf16(lo, hi); }

__host__ __device__ __forceinline__ int rope_sigma_inv(int a) { const int head = a >> 7, half = (a >> 6) & 1, jj = a & 63, j = jj & 31, hi = jj >> 5; const int u = head * 64 + half * 32 + j; return (u >> 2) * 8 + (u & 3) + 4 * hi; }
struct RowMapWin {
    bf16* main_; bf16* lr; bf16* m;
    __device__ __forceinline__ bf16* operator()(int s) const {
        if (s < 3072) return main_ + (size_t)s * 1024;
        if (s < 3104) return lr + (size_t)(s - 3072) * 1024;
        if (s < 6176) { int n = s - 32; const int tile = n >> 8; if (tile >= 12 && tile < 16) n = (n & ~255) + rope_sigma_inv(n & 255); return main_ + (size_t)n * 1024; }
        return m + (size_t)(s - 6176) * 1024;
    }
};
struct RowMapId { bf16* base; int K; __device__ __forceinline__ bf16* operator()(int s) const { return base + (size_t)s * K; } };
template <class RowMap> __device__ __forceinline__ void cvt_item(const float* W, int N, LAS float* scr, int item, int lane, const RowMap& rm) {
    const int nblk = N / 32, kb = item / nblk, nb = item % nblk, k0 = 64 * kb, n0 = 32 * nb;
#pragma unroll 8
    for (int i = 0; i < 32; ++i) { const int kk = 2 * i + (lane >> 5); scr[kk * 33 + (lane & 31)] = W[(size_t)(k0 + kk) * N + n0 + (lane & 31)]; }
    LDS_WAIT();
    const int c = lane & 7;
#pragma unroll
    for (int j = 0; j < 4; ++j) { const int n = (lane >> 3) + 8 * j; const LAS float* s = scr + (8 * c) * 33 + n;
        v4u o; o.x = pk2(s[0 * 33], s[1 * 33]); o.y = pk2(s[2 * 33], s[3 * 33]); o.z = pk2(s[4 * 33], s[5 * 33]); o.w = pk2(s[6 * 33], s[7 * 33]);
        *(v4u*)(rm(n0 + n) + k0 + 8 * c) = o; }
    LDS_WAIT();
}
__device__ __forceinline__ void p_convert_weights(LAS unsigned char* lds, const float* w_in, const float* wbg, const float* wbr, const float* w_out, bf16* WinT_main, bf16* WinT_lr, bf16* WinT_m, bf16* WbgT, bf16* WbrT, bf16* WoutT) {
    int tidx_ = threadIdx.x; asm volatile("" : "+v"(tidx_));
    const int wave = tidx_ >> 6, lane = tidx_ & 63;
    LAS float* scr = (LAS float*)(lds + 32768 + wave * 12288);
    const int gw = blockIdx.x * 8 + wave, NGW = gridDim.x * 8;
    constexpr int I_IN = 16 * (INW / 32), I_SQ = 16 * 32;
    for (int it = gw; it < I_IN + 3 * I_SQ; it += NGW) {
        int r = it;
        if (r < I_IN) { RowMapWin rm{WinT_main, WinT_lr, WinT_m}; cvt_item(w_in, INW, scr, r, lane, rm); continue; } r -= I_IN;
        if (r < I_SQ) { RowMapId rm{WbgT, 1024}; cvt_item(wbg, 1024, scr, r, lane, rm); continue; } r -= I_SQ;
        if (r < I_SQ) { RowMapId rm{WbrT, 1024}; cvt_item(wbr, 1024, scr, r, lane, rm); continue; } r -= I_SQ;
        { RowMapId rm{WoutT, 1024}; cvt_item(w_out, 1024, scr, r, lane, rm); }
    }
}
using pg8::Unit;
struct EpiProjF {
    static constexpr bool PERM = true, AFTER_DRAIN = false;
    bf16 *GQ, *GK, *GV, *GG, *RQ, *RK, *RV, *RG; const float2* rope;
    __device__ __forceinline__ void operator()(const f32x4 (&acc)[2][2][4][2], const Unit& u, int wr, int wc, int fr, int fq) const {
        const float s = 0.08838834764831845f;
        const int pn = u.pn; bf16* base; int ld, tile0; float scale = 1.f; bool isrope = false;
        if (pn < 2) { base = GQ; ld = 512; tile0 = 0; scale = s; }
        else if (pn < 4) { base = GK; ld = 512; tile0 = 2; }
        else if (pn < 8) { base = GV; ld = 1024; tile0 = 4; }
        else if (pn < 12) { base = GG; ld = 1024; tile0 = 8; }
        else if (pn < 14) { base = RQ; ld = 512; tile0 = 12; isrope = true; }
        else if (pn < 16) { base = RK; ld = 512; tile0 = 14; scale = s; isrope = true; }
        else if (pn < 20) { base = RV; ld = 1024; tile0 = 16; }
        else { base = RG; ld = 1024; tile0 = 20; }
        const int colt = (pn - tile0) * 256, row0 = u.pm * 256 + wr * 64 + fr;
        if (!isrope) {
#pragma unroll
            for (int ai = 0; ai < 2; ++ai)
#pragma unroll
                for (int m = 0; m < 4; ++m) { bf16* rowp = base + (size_t)(row0 + ai * 128 + m * 16) * ld + colt + wc * 32 + 8 * fq;
#pragma unroll
                    for (int bj = 0; bj < 2; ++bj) { const f32x4 v0 = acc[ai][bj][m][0] * scale, v1 = acc[ai][bj][m][1] * scale;
                        v4u w; w.x = pk2(v0[0], v0[1]); w.y = pk2(v0[2], v0[3]); w.z = pk2(v1[0], v1[1]); w.w = pk2(v1[2], v1[3]);
                        *(v4u*)(rowp + bj * 128) = w; } }
        } else {
#pragma unroll
            for (int ai = 0; ai < 2; ++ai)
#pragma unroll
                for (int m = 0; m < 4; ++m) { const int r = row0 + ai * 128 + m * 16; const bool lat = r < T; const int l = r & (L - 1);
#pragma unroll
                    for (int bj = 0; bj < 2; ++bj) { const int c0 = 128 * bj + 32 * wc + 8 * fq, u4 = (c0 >> 3) * 4, head = u4 >> 6, half = (u4 >> 5) & 1, j = u4 & 31;
                        const f32x4 v0 = acc[ai][bj][m][0] * scale, v1 = acc[ai][bj][m][1] * scale;
                        f32x4 o1 = v0, o2 = v1;
                        if (lat) { const int pos = half ? (l & 63) : (l >> 6); const float2* cs = rope + pos * 32 + j;
#pragma unroll
                            for (int i = 0; i < 4; ++i) { const float2 t = cs[i]; o1[i] = v0[i] * t.x - v1[i] * t.y; o2[i] = v0[i] * t.y + v1[i] * t.x; } }
                        bf16* p = base + (size_t)r * 512 + colt + head * 128 + half * 64 + j;
                        v2u w1; w1.x = pk2(o1[0], o1[1]); w1.y = pk2(o1[2], o1[3]); v2u w2; w2.x = pk2(o2[0], o2[1]); w2.y = pk2(o2[2], o2[3]);
                        *(v2u*)p = w1; *(v2u*)(p + 32) = w2; } }
        }
    }
};
struct ProjOrder {
    pg8::StaticOrder so; int G, c;
    __device__ __forceinline__ void init(int G_, int c_) { so.init(T, 6144, G_, c_); G = G_; c = c_; }
    __device__ __forceinline__ bool next(int i, Unit& u) const {
        const int Lx = i * G + c;
        if (Lx < 1536) return so.next(i, u);
        const int j = Lx - 1536; if (j >= 24) return false;
        const int t = j % 12; u.pm = 64 + j / 12; u.pn = t < 2 ? 2 + t : t < 6 ? 4 + (t - 2) : t < 8 ? 14 + (t - 6) : 16 + (t - 8); u.k = 0; return true;
    }
    __device__ __forceinline__ void a_ready(const Unit&) const {}
    __device__ __forceinline__ void done(const Unit&) const {}
    __device__ __forceinline__ const pg8::bf16_t* a_base(const pg8::Gemm& g, const Unit&) const { return g.A; }
    __device__ __forceinline__ const pg8::bf16_t* b_base(const pg8::Gemm& g, const Unit&) const { return g.Bt; }
};
__device__ __forceinline__ float sigmoid_f(float v) { return 1.f / (1.f + __expf(-v)); }
struct ChainOrder {
    pg8::StaticOrder so; const pg8::bf16_t* A[4]; const pg8::bf16_t* B[4];
    __device__ __forceinline__ bool next(int i, Unit& u) const { if (i >= 4) return false; const bool ok = so.next(0, u); u.k = i; return ok; }
    __device__ __forceinline__ void a_ready(const Unit&) const {}
    __device__ __forceinline__ void done(const Unit&) const {}
    __device__ __forceinline__ const pg8::bf16_t* a_base(const pg8::Gemm&, const Unit& u) const { return u.k == 0 ? A[0] : u.k == 1 ? A[1] : u.k == 2 ? A[2] : A[3]; }
    __device__ __forceinline__ const pg8::bf16_t* b_base(const pg8::Gemm&, const Unit& u) const { return u.k == 0 ? B[0] : u.k == 1 ? B[1] : u.k == 2 ? B[2] : B[3]; }
};
struct EpiChain {
    static constexpr bool PERM = true, AFTER_DRAIN = false;
    bf16* Y; bf16* S2;
    __device__ __forceinline__ void operator()(const f32x4 (&acc)[2][2][4][2], const Unit& u, int wr, int wc, int fr, int fq) const {
        const int row0 = u.pm * 256 + wr * 64 + fr, col0 = u.pn * 256 + wc * 32 + 8 * fq; const int mode = u.k;
        bf16* dst = mode == 2 ? S2 : Y;
#pragma unroll
        for (int ai = 0; ai < 2; ++ai)
#pragma unroll
            for (int m = 0; m < 4; ++m) { const size_t ro = (size_t)(row0 + ai * 128 + m * 16) * 1024 + col0;
#pragma unroll
                for (int bj = 0; bj < 2; ++bj) { const f32x4 a0 = acc[ai][bj][m][0], a1 = acc[ai][bj][m][1]; float o[8];
                    if (mode == 0 || mode == 2) {
#pragma unroll
                        for (int i = 0; i < 4; ++i) { o[i] = sigmoid_f(a0[i]); o[4 + i] = sigmoid_f(a1[i]); }
                    } else {
                        const v4u yv = *(const v4u*)(Y + ro + bj * 128); const unsigned yw[4] = {yv.x, yv.y, yv.z, yv.w}; float y[8];
#pragma unroll
                        for (int i = 0; i < 4; ++i) { y[2 * i] = __uint_as_float(yw[i] << 16); y[2 * i + 1] = __uint_as_float(yw[i] & 0xffff0000u); }
                        if (mode == 1) {
#pragma unroll
                            for (int i = 0; i < 4; ++i) { o[i] = y[i] * a0[i]; o[4 + i] = y[4 + i] * a1[i]; }
                        } else {
                            const v4u sv = *(const v4u*)(S2 + ro + bj * 128); const unsigned sw[4] = {sv.x, sv.y, sv.z, sv.w}; float sg[8];
#pragma unroll
                            for (int i = 0; i < 4; ++i) { sg[2 * i] = __uint_as_float(sw[i] << 16); sg[2 * i + 1] = __uint_as_float(sw[i] & 0xffff0000u); }
#pragma unroll
                            for (int i = 0; i < 4; ++i) { o[i] = y[i] + sg[i] * a0[i]; o[4 + i] = y[4 + i] + sg[4 + i] * a1[i]; }
                        }
                    }
                    v4u w; w.x = pk2(o[0], o[1]); w.y = pk2(o[2], o[3]); w.z = pk2(o[4], o[5]); w.w = pk2(o[6], o[7]);
                    *(v4u*)(dst + ro + bj * 128) = w; } }
    }
};
struct EpiOutF {
    static constexpr bool PERM = false, AFTER_DRAIN = false;
    const float* x; const float* ada; float* H1;
    __device__ __forceinline__ void operator()(const f32x4 (&acc)[2][2][4][2], const Unit& u, int wr, int wc, int fr, int fq) const {
        const int row0 = u.pm * 256 + wr * 64 + fr, col0 = u.pn * 256 + wc * 32 + 4 * fq;
        const float* g1 = ada + ((u.pm * 256) / L) * 6144 + 2048;
        f32x4 gv[2][2];
#pragma unroll
        for (int bj = 0; bj < 2; ++bj)
#pragma unroll
            for (int n = 0; n < 2; ++n) gv[bj][n] = *(const f32x4*)(g1 + col0 + bj * 128 + n * 16);
#pragma unroll
        for (int ai = 0; ai < 2; ++ai)
#pragma unroll
            for (int m = 0; m < 4; ++m) { const size_t ro = (size_t)(row0 + ai * 128 + m * 16) * 1024 + col0;
#pragma unroll
                for (int bj = 0; bj < 2; ++bj)
#pragma unroll
                    for (int n = 0; n < 2; ++n) { const f32x4 xv = *(const f32x4*)(x + ro + bj * 128 + n * 16); *(f32x4*)(H1 + ro + bj * 128 + n * 16) = xv + gv[bj][n] * acc[ai][bj][m][n]; } }
    }
};
__device__ __forceinline__ void p_lr(LAS unsigned char* lds, const bf16* HL, const bf16* Wlr, float* LR) {
    int tidx_ = threadIdx.x; asm volatile("" : "+v"(tidx_));
    const int tid = tidx_, w = tid >> 6, lane = tid & 63, r = lane & 31, h = lane >> 5;
    LAS float* red = (LAS float*)lds;
    for (int unit = blockIdx.x; unit < TT / 64; unit += gridDim.x) {
        const int row0 = unit * 64;
        f32x16 acc0, acc1;
#pragma unroll
        for (int i = 0; i < 16; ++i) { acc0[i] = 0.f; acc1[i] = 0.f; }
#pragma unroll
        for (int ks = 0; ks < 8; ++ks) { const int k = 128 * w + 16 * ks + 8 * h;
            const bf16x8 a0 = *(const bf16x8*)(HL + (size_t)(row0 + r) * 1024 + k), a1 = *(const bf16x8*)(HL + (size_t)(row0 + 32 + r) * 1024 + k), b = *(const bf16x8*)(Wlr + (size_t)r * 1024 + k);
            acc0 = __builtin_amdgcn_mfma_f32_32x32x16_bf16(a0, b, acc0, 0, 0, 0); acc1 = __builtin_amdgcn_mfma_f32_32x32x16_bf16(a1, b, acc1, 0, 0, 0); }
#pragma unroll
        for (int i = 0; i < 16; ++i) { red[((w * 2 + 0) * 16 + i) * 64 + lane] = acc0[i]; red[((w * 2 + 1) * 16 + i) * 64 + lane] = acc1[i]; }
        __syncthreads();
#pragma unroll
        for (int q = 0; q < 4; ++q) { const int o = tid + q * NTHR;
            float s = 0.f;
#pragma unroll
            for (int ww = 0; ww < 8; ++ww) s += red[ww * 2048 + o];
            const int ln = o & 63, reg = (o >> 6) & 15, tile = o >> 10; const int col = ln & 31, row = (reg & 3) + 8 * (reg >> 2) + 4 * (ln >> 5);
            LR[(size_t)(row0 + tile * 32 + row) * 32 + col] = s; }
        __syncthreads();
    }
}
typedef short s16x4 __attribute__((ext_vector_type(4)));
typedef __bf16 bf16x2v __attribute__((ext_vector_type(2)));
typedef float f32x2v __attribute__((ext_vector_type(2)));
__device__ __forceinline__ unsigned pkbf(float lo, float hi) { f32x2v f = {lo, hi}; return __builtin_bit_cast(unsigned, __builtin_convertvector(f, bf16x2v)); }
__device__ __forceinline__ float bflo(unsigned w) { return __uint_as_float(w << 16); }
__device__ __forceinline__ float bfhi(unsigned w) { return __uint_as_float(w & 0xffff0000u); }
constexpr int QP = 272, VP = 512, PP = 144;
constexpr int SC_QT = 0, SC_KT = 17408, SC_V = 34816, SC_P = 67584, SC_RQ = 76800, SC_RK = 93184, SC_LR = 109568, SC_E = 113664, SC_PRE = 114176, SC_WG = 118272, SC_BG = 126464, SC_GN = 126976, SC_END = 128000;
constexpr int OPITCH = 1040;
#define SC_BAR() __builtin_amdgcn_s_barrier()
#define SC_WAIT_L0() asm volatile("s_waitcnt lgkmcnt(0)" ::: "memory")
#define SC_WAIT_V(n) asm volatile("s_waitcnt vmcnt(" #n ")" ::: "memory")
constexpr int ST_WORDS = 16384;
struct ScanBufs { const bf16 *GQ, *GK, *GV, *RQ, *RK, *RV; bf16 *GG, *RG; const float *LR, *lrw, *lrb, *gnorm; unsigned* ST; float* DD; unsigned* OFT; };
__device__ __forceinline__ int crow(int reg, int h) { return (reg & 3) + 8 * (reg >> 2) + 4 * h; }

__device__ __forceinline__ void scan_dma_qk(LAS unsigned char* lds, int dst, const bf16* Xh, size_t row0, int w, int lane) {
    const unsigned voff = (unsigned)((lane >> 4) * 1024 + (lane & 15) * 16);
#pragma unroll
    for (int i = 0; i < 2; ++i) { const int j = 2 * w + i; const char* sb = (const char*)(Xh + (row0 + 4 * j) * 512);
        __builtin_amdgcn_global_load_lds((const unsigned*)(sb + voff), (LAS unsigned*)(lds + dst + j * 1024), 16, 0, 0); }
}
__device__ __forceinline__ void scan_dma_lr(LAS unsigned char* lds, const float* LRd, size_t row0, int w, int lane) {
    const unsigned voff = (unsigned)((lane >> 4) * 128 + (lane & 15) * 4);
#pragma unroll
    for (int i = 0; i < 2; ++i) { const int j = 2 * w + i; const char* sb = (const char*)(LRd + (row0 + 4 * j) * 32);
        __builtin_amdgcn_global_load_lds((const unsigned*)(sb + voff), (LAS unsigned*)(lds + SC_LR + j * 256), 4, 0, 0); }
}
__device__ __forceinline__ void scan_dma_v(LAS unsigned char* lds, const bf16* Vh, size_t row0, int w, int lane) {
#pragma unroll
    for (int i = 0; i < 4; ++i) { const int j = 4 * w + i; const char* sb = (const char*)(Vh + (row0 + 2 * j) * 1024);
        const unsigned voff = (unsigned)((lane >> 5) * 2048 + (((lane & 31) ^ (2 * ((2 * i + (lane >> 5)) & 3))) * 16));
        __builtin_amdgcn_global_load_lds((const unsigned*)(sb + voff), (LAS unsigned*)(lds + SC_V + j * 1024), 16, 0, 0); }
}
template <bool NEED_Q> __device__ __forceinline__ f32x2v scan_prep(LAS unsigned char* lds, int mixer, int dir, float lg) {
    int tid = threadIdx.x; asm volatile("" : "+v"(tid));
    const int w = __builtin_amdgcn_readfirstlane(tid >> 6), dkp = tid & 63;
    f32x2v la[8];
    if (mixer == 0) {
        const f32x2v bgv = ((const LAS f32x2v*)(lds + SC_BG))[dkp];
#pragma unroll
        for (int i = 0; i < 8; ++i) la[i] = bgv;
#pragma unroll
        for (int r4 = 0; r4 < 4; ++r4) { const LAS f32x2v* wgp = (const LAS f32x2v*)(lds + SC_WG) + (4 * r4) * 64 + dkp; const f32x2v w0 = wgp[0], w1 = wgp[64], w2 = wgp[128], w3 = wgp[192];
#pragma unroll
            for (int ih = 0; ih < 2; ++ih) { f32x4 xx[4];
#pragma unroll
                for (int i = 0; i < 4; ++i) xx[i] = *(const LAS f32x4*)(lds + SC_LR + (8 * w + 4 * ih + i) * 64 + r4 * 16);
#pragma unroll
                for (int i = 0; i < 4; ++i) { la[4 * ih + i] += w0 * xx[i][0]; la[4 * ih + i] += w1 * xx[i][1]; la[4 * ih + i] += w2 * xx[i][2]; la[4 * ih + i] += w3 * xx[i][3]; } } }
#pragma unroll
        for (int i = 0; i < 8; ++i) { const f32x2v z = la[i]; f32x2v ls;
            ls.x = fminf(z.x, 0.f) - __builtin_amdgcn_logf(1.f + __builtin_amdgcn_exp2f(-fabsf(z.x))); ls.y = fminf(z.y, 0.f) - __builtin_amdgcn_logf(1.f + __builtin_amdgcn_exp2f(-fabsf(z.y))); la[i] = ls * (1.f / 16.f); }
    } else {
#pragma unroll
        for (int i = 0; i < 8; ++i) { la[i].x = lg; la[i].y = lg; }
    }
    if (dir == 0) {
#pragma unroll
        for (int i = 1; i < 8; ++i) la[i] += la[i - 1];
    } else {
#pragma unroll
        for (int i = 6; i >= 0; --i) la[i] += la[i + 1];
    }
    ((LAS f32x2v*)(lds + SC_PRE))[w * 64 + dkp] = dir == 0 ? la[7] : la[0];
    SC_WAIT_L0(); SC_BAR();
    f32x2v off = {0.f, 0.f}, tot = {0.f, 0.f};
    { f32x2v pp[8];
#pragma unroll
      for (int w2 = 0; w2 < 8; ++w2) pp[w2] = ((const LAS f32x2v*)(lds + SC_PRE))[w2 * 64 + dkp];
#pragma unroll
      for (int w2 = 0; w2 < 8; ++w2) { tot += pp[w2]; off += pp[w2] * ((dir == 0 ? (w2 < w) : (w2 > w)) ? 1.f : 0.f); } }
    unsigned kwv[8], qwv[8];
#pragma unroll
    for (int i = 0; i < 8; ++i) { kwv[i] = *(const LAS unsigned*)(lds + SC_RK + (8 * w + i) * 256 + dkp * 4); if (NEED_Q) qwv[i] = *(const LAS unsigned*)(lds + SC_RQ + (8 * w + i) * 256 + dkp * 4); }
#pragma unroll
    for (int i = 0; i < 8; ++i) { const f32x2v Bv = la[i] + off; const int t = 8 * w + i;
        const float e0 = __builtin_amdgcn_exp2f(-Bv.x), e1 = __builtin_amdgcn_exp2f(-Bv.y);
        *(LAS unsigned*)(lds + SC_KT + t * QP + dkp * 4) = pkbf(bflo(kwv[i]) * e0, bfhi(kwv[i]) * e1);
        if (NEED_Q) { const float f0 = __builtin_amdgcn_exp2f(Bv.x), f1 = __builtin_amdgcn_exp2f(Bv.y); *(LAS unsigned*)(lds + SC_QT + t * QP + dkp * 4) = pkbf(bflo(qwv[i]) * f0, bfhi(qwv[i]) * f1); } }
    if (w == 0) { f32x2v ev; ev.x = __builtin_amdgcn_exp2f(tot.x); ev.y = __builtin_amdgcn_exp2f(tot.y); ((LAS f32x2v*)(lds + SC_E))[dkp] = ev; }
    SC_WAIT_L0();
    return tot;
}
__device__ __forceinline__ bf16x8 scan_vfrag(LAS unsigned char* lds, int w, int lane, int s) {
    const int h = lane >> 5, blk = (lane >> 4) & 1, q4 = (lane & 15) >> 2, p4 = lane & 3;
    const int cb = 16 * ((4 * w + 2 * blk + (p4 >> 1)) ^ (2 * q4)) + 8 * (p4 & 1);
    const s16x4 a = __builtin_amdgcn_ds_read_tr16_b64_v4i16((LAS s16x4*)(lds + SC_V + VP * (16 * s + 8 * h + q4) + cb));
    const s16x4 b = __builtin_amdgcn_ds_read_tr16_b64_v4i16((LAS s16x4*)(lds + SC_V + VP * (16 * s + 8 * h + 4 + q4) + cb));
    return (bf16x8){a[0], a[1], a[2], a[3], b[0], b[1], b[2], b[3]};
}
__device__ __forceinline__ void scan_update(LAS unsigned char* lds, int w, int lane, f32x16 (&S)[4]) {
    const int h = lane >> 5, blk = (lane >> 4) & 1, q4 = (lane & 15) >> 2, p4 = lane & 3;
#pragma unroll
    for (int s = 0; s < 4; ++s) {
        const bf16x8 vf = scan_vfrag(lds, w, lane, s);
        bf16x8 ak[4];
#pragma unroll
        for (int i = 0; i < 4; ++i) {
            const s16x4 a = __builtin_amdgcn_ds_read_tr16_b64_v4i16((LAS s16x4*)(lds + SC_KT + QP * (16 * s + 8 * h + q4) + 64 * i + 32 * blk + 8 * p4));
            const s16x4 b = __builtin_amdgcn_ds_read_tr16_b64_v4i16((LAS s16x4*)(lds + SC_KT + QP * (16 * s + 8 * h + 4 + q4) + 64 * i + 32 * blk + 8 * p4));
            ak[i] = (bf16x8){a[0], a[1], a[2], a[3], b[0], b[1], b[2], b[3]}; }
#pragma unroll
        for (int i = 0; i < 4; ++i) S[i] = __builtin_amdgcn_mfma_f32_32x32x16_bf16(ak[i], vf, S[i], 0, 0, 0);
    }
#pragma unroll
    for (int i = 0; i < 4; ++i)
#pragma unroll
        for (int g = 0; g < 4; ++g) { const f32x4 ev = *(const LAS f32x4*)(lds + SC_E + (32 * i + 8 * g + 4 * h) * 4);
#pragma unroll
            for (int j = 0; j < 4; ++j) S[i][4 * g + j] *= ev[j]; }
}
__device__ __forceinline__ void scan_load_state(const unsigned* st, int w, int lane, f32x16 (&S)[4]) {
#pragma unroll
    for (int i = 0; i < 4; ++i) {
#pragma unroll
        for (int rp = 0; rp < 8; ++rp) { const unsigned u = st[((w * 4 + i) * 8 + rp) * 64 + lane]; S[i][2 * rp] = bflo(u); S[i][2 * rp + 1] = bfhi(u); }
        __builtin_amdgcn_sched_barrier(0);
    }
}
__device__ __forceinline__ void scan_store_state(unsigned* st, int w, int lane, const f32x16 (&S)[4]) {
#pragma unroll
    for (int i = 0; i < 4; ++i)
#pragma unroll
        for (int rp = 0; rp < 8; ++rp) st[((w * 4 + i) * 8 + rp) * 64 + lane] = pkbf(S[i][2 * rp], S[i][2 * rp + 1]);
}
__device__ __forceinline__ void scan_gate_weights(LAS unsigned char* lds, const ScanBufs& p, int mixer, int dir, int h, int tid) {
    asm volatile("" : "+v"(tid));
    if (mixer == 0) {
        const float* wsrc = p.lrw + (size_t)(dir * 16) * 512 + h * 128; const unsigned wo = (unsigned)((tid >> 7) * 512 + (tid & 127)) * 4u;
#pragma unroll
        for (int k = 0; k < 4; ++k) ((LAS float*)(lds + SC_WG))[tid + NTHR * k] = 1.44269504089f * *(const float*)((const char*)(wsrc + 4 * 512 * k) + wo);
        if (tid < 128) ((LAS float*)(lds + SC_BG))[tid] = 1.44269504089f * *(const float*)((const char*)(p.lrb + dir * 512 + h * 128) + (unsigned)tid * 4u);
    }
}
__device__ __forceinline__ void p_scan_a(LAS unsigned char* lds, const ScanBufs& p) {
    for (int unit = blockIdx.x; unit < 512; unit += gridDim.x) {
        int tid = threadIdx.x; asm volatile("" : "+v"(tid));
        const int w = __builtin_amdgcn_readfirstlane(tid >> 6), lane = tid & 63, dkp = tid & 63;
        const int chain = unit >> 4, slot = unit & 15, dir = chain & 1, h = (chain >> 1) & 3, b = (chain >> 3) & 1, mixer = chain >> 4;
        const bf16* Kh = (mixer ? p.RK : p.GK) + h * 128; const bf16* Vh = (mixer ? p.RV : p.GV) + h * 256; const float* LRd = p.LR + dir * 16;
        const float lg = 1.44269504089f * log1pf(-exp2f(-(dir ? 5.5f : 5.0f) - (float)h));
        scan_gate_weights(lds, p, mixer, dir, h, tid);
        const int nch = slot == 0 ? 4 : 8;
        const int seg = dir == 0 ? slot - 1 : 16 - slot;
        const size_t base = slot == 0 ? (size_t)T + b * CTX : (size_t)b * L + seg * 512;
        f32x16 S[4];
#pragma unroll
        for (int i = 0; i < 4; ++i)
#pragma unroll
            for (int j = 0; j < 16; ++j) S[i][j] = 0.f;
        f32x2v dsum = {0.f, 0.f};
        { const size_t r0 = base + (dir == 0 ? 0 : nch - 1) * 64; scan_dma_qk(lds, SC_RK, Kh, r0, w, lane); scan_dma_lr(lds, LRd, r0, w, lane); }
        SC_WAIT_L0(); SC_BAR();
        for (int cc = 0; cc < nch; ++cc) {
            int tid = threadIdx.x; asm volatile("" : "+v"(tid)); const int lane = tid & 63;
            const int chunk = dir == 0 ? cc : nch - 1 - cc; const int cn = cc + 1 < nch ? (dir == 0 ? cc + 1 : nch - 2 - cc) : chunk;
            scan_dma_v(lds, Vh, base + chunk * 64, w, lane);
            SC_WAIT_V(4);
            const f32x2v tot = scan_prep<false>(lds, mixer, dir, lg);
            dsum += tot;
            scan_dma_qk(lds, SC_RK, Kh, base + cn * 64, w, lane); scan_dma_lr(lds, LRd, base + cn * 64, w, lane);
            SC_WAIT_V(4); SC_BAR();
            scan_update(lds, w, lane, S);
            SC_WAIT_L0(); SC_BAR();
        }
        scan_store_state(p.ST + (size_t)(chain * 16 + slot) * ST_WORDS, w, lane, S);
        if (w == 0) { f32x2v dv; dv.x = __builtin_amdgcn_exp2f(dsum.x); dv.y = __builtin_amdgcn_exp2f(dsum.y); *(f32x2v*)(p.DD + (size_t)(chain * 16 + slot) * 128 + 2 * dkp) = dv; }
    }
}
__device__ __forceinline__ void p_scan_b(const ScanBufs& p) {
    int tidx_ = threadIdx.x; asm volatile("" : "+v"(tidx_));
    for (int e = blockIdx.x * NTHR + tidx_; e < 32 * ST_WORDS; e += gridDim.x * NTHR) {
        const int chain = e / ST_WORDS, wi = e % ST_WORDS; const int lane = wi & 63, rp = (wi >> 6) & 7, i = (wi >> 9) & 3;
        const int dk0 = 32 * i + crow(2 * rp, lane >> 5);
        unsigned* st = p.ST + (size_t)chain * 16 * ST_WORDS + wi; const float* dd = p.DD + (size_t)chain * 16 * 128 + dk0;
        unsigned u = st[0]; float s0 = bflo(u), s1 = bfhi(u);
#pragma unroll 5
        for (int j = 1; j < 16; ++j) { const unsigned uu = st[(size_t)j * ST_WORDS]; const f32x2v d = *(const f32x2v*)(dd + j * 128);
            s0 = d.x * s0 + bflo(uu); s1 = d.y * s1 + bfhi(uu); st[(size_t)j * ST_WORDS] = pkbf(s0, s1); }
    }
}
__device__ __forceinline__ void p_scan_c(LAS unsigned char* lds, const ScanBufs& p, bool dry = false) {
    for (int unit = blockIdx.x; unit < 256; unit += gridDim.x) {
        int tid = threadIdx.x; asm volatile("" : "+v"(tid));
        const int w = __builtin_amdgcn_readfirstlane(tid >> 6), lane = tid & 63;
        const int mixer = unit >> 7, b = (unit >> 6) & 1, h = (unit >> 4) & 3, seg = unit & 15;
        const bf16* Qh = (mixer ? p.RQ : p.GQ) + h * 128; const bf16* Kh = (mixer ? p.RK : p.GK) + h * 128; const bf16* Vh = (mixer ? p.RV : p.GV) + h * 256;
        bf16* Gh = (mixer ? p.RG : p.GG) + h * 256;
        unsigned* oft = p.OFT + (size_t)unit * 65536;
        const size_t base = (size_t)b * L + seg * 512;
        if (tid < 256) ((LAS float*)(lds + SC_GN))[tid] = mixer == 0 ? p.gnorm[tid] : 1.f;
        for (int dir = 0; dir < 2; ++dir) {
            const int chain = ((mixer * 2 + b) * 4 + h) * 2 + dir, slot = dir == 0 ? seg : 15 - seg;
            const float lg = 1.44269504089f * log1pf(-exp2f(-(dir ? 5.5f : 5.0f) - (float)h));
            scan_gate_weights(lds, p, mixer, dir, h, tid);
            f32x16 S[4]; { int l2 = threadIdx.x; asm volatile("" : "+v"(l2)); scan_load_state(p.ST + (size_t)(chain * 16 + slot) * ST_WORDS, w, l2 & 63, S); }
            { int l3 = threadIdx.x; asm volatile("" : "+v"(l3)); const int lane = l3 & 63; const size_t r0 = base + (dir == 0 ? 0 : 7) * 64; scan_dma_qk(lds, SC_RQ, Qh, r0, w, lane); scan_dma_qk(lds, SC_RK, Kh, r0, w, lane); scan_dma_lr(lds, p.LR + dir * 16, r0, w, lane); }
            SC_WAIT_L0(); SC_BAR();
            for (int cc = 0; cc < 8; ++cc) {
                int tid = threadIdx.x; asm volatile("" : "+v"(tid));
                const int lane = tid & 63, r = lane & 31, h2 = lane >> 5;
                const int chunk = dir == 0 ? cc : 7 - cc; const size_t row0 = base + chunk * 64; const int cn = cc < 7 ? (dir == 0 ? cc + 1 : 6 - cc) : chunk;
                scan_dma_v(lds, Vh, row0, w, lane);
                if (dir == 0 && cc > 0) SC_WAIT_V(20); else SC_WAIT_V(4);
                scan_prep<true>(lds, mixer, dir, lg);
                { const size_t rn = base + cn * 64; scan_dma_qk(lds, SC_RQ, Qh, rn, w, lane); scan_dma_qk(lds, SC_RK, Kh, rn, w, lane); scan_dma_lr(lds, p.LR + dir * 16, rn, w, lane); }
                SC_BAR();
                unsigned ou[16];
#pragma unroll
                for (int q = 0; q < 16; ++q) ou[q] = 0u;
                if (dir == 1) {
#pragma unroll
                    for (int ti = 0; ti < 2; ++ti)
#pragma unroll
                        for (int rp = 0; rp < 8; ++rp) ou[ti * 8 + rp] = oft[(((chunk * 8 + w) * 2 + ti) * 8 + rp) * 64 + lane];
                }
                { const int lr = lane & 15, lq = lane >> 4;
#pragma unroll
                  for (int tt = 0; tt < 2; ++tt) { const int id = 2 * w + tt, ti16 = id >> 2, si16 = id & 3; f32x4 acc = {0.f, 0.f, 0.f, 0.f};
                      bf16x8 ka[4], qb[4];
#pragma unroll
                      for (int kk = 0; kk < 4; ++kk) { ka[kk] = *(const LAS bf16x8*)(lds + SC_KT + (16 * si16 + lr) * QP + (kk * 32 + 8 * lq) * 2); qb[kk] = *(const LAS bf16x8*)(lds + SC_QT + (16 * ti16 + lr) * QP + (kk * 32 + 8 * lq) * 2); }
#pragma unroll
                      for (int kk = 0; kk < 4; ++kk) acc = __builtin_amdgcn_mfma_f32_16x16x32_bf16(ka[kk], qb[kk], acc, 0, 0, 0);
                      const int t = 16 * ti16 + lr, s0 = 16 * si16 + 4 * lq; float pv[4];
#pragma unroll
                      for (int j = 0; j < 4; ++j) { const int s = s0 + j; const bool keep = dir == 0 ? (s <= t) : (s > t); pv[j] = keep ? acc[j] : 0.f; }
                      v2u pw; pw.x = pkbf(pv[0], pv[1]); pw.y = pkbf(pv[2], pv[3]); *(LAS v2u*)(lds + SC_P + t * PP + s0 * 2) = pw; } }
                SC_WAIT_V(6); SC_WAIT_L0(); SC_BAR();
                f32x16 o[2];
#pragma unroll
                for (int ti = 0; ti < 2; ++ti)
#pragma unroll
                    for (int rp = 0; rp < 8; ++rp) { o[ti][2 * rp] = bflo(ou[ti * 8 + rp]); o[ti][2 * rp + 1] = bfhi(ou[ti * 8 + rp]); }
#pragma unroll
                for (int i = 0; i < 4; ++i) {
                    bf16x8 aq[2][2];
#pragma unroll
                    for (int s2 = 0; s2 < 2; ++s2)
#pragma unroll
                        for (int ti = 0; ti < 2; ++ti) { const LAS unsigned char* qa = lds + SC_QT + (32 * ti + r) * QP + (32 * i + 16 * s2 + 4 * h2) * 2;
                            const v2u a0 = *(const LAS v2u*)qa, a1 = *(const LAS v2u*)(qa + 16); v4u aw; aw.x = a0.x; aw.y = a0.y; aw.z = a1.x; aw.w = a1.y; aq[s2][ti] = __builtin_bit_cast(bf16x8, aw); }
#pragma unroll
                    for (int s2 = 0; s2 < 2; ++s2) {
                        v4u sbw; sbw.x = pkbf(S[i][8 * s2], S[i][8 * s2 + 1]); sbw.y = pkbf(S[i][8 * s2 + 2], S[i][8 * s2 + 3]); sbw.z = pkbf(S[i][8 * s2 + 4], S[i][8 * s2 + 5]); sbw.w = pkbf(S[i][8 * s2 + 6], S[i][8 * s2 + 7]);
                        const bf16x8 sb = __builtin_bit_cast(bf16x8, sbw);
#pragma unroll
                        for (int ti = 0; ti < 2; ++ti) o[ti] = __builtin_amdgcn_mfma_f32_32x32x16_bf16(aq[s2][ti], sb, o[ti], 0, 0, 0); } }
#pragma unroll
                for (int kp = 0; kp < 2; ++kp) { bf16x8 vf[2], pa[2][2];
#pragma unroll
                    for (int k2 = 0; k2 < 2; ++k2) { const int ks = 2 * kp + k2; vf[k2] = scan_vfrag(lds, w, lane, ks);
#pragma unroll
                        for (int ti = 0; ti < 2; ++ti) pa[k2][ti] = *(const LAS bf16x8*)(lds + SC_P + (32 * ti + r) * PP + (16 * ks + 8 * h2) * 2); }
#pragma unroll
                    for (int k2 = 0; k2 < 2; ++k2)
#pragma unroll
                        for (int ti = 0; ti < 2; ++ti) o[ti] = __builtin_amdgcn_mfma_f32_32x32x16_bf16(pa[k2][ti], vf[k2], o[ti], 0, 0, 0); }
                scan_update(lds, w, lane, S);
                if (dir == 0) {
#pragma unroll
                    for (int ti = 0; ti < 2; ++ti)
#pragma unroll
                        for (int rp = 0; rp < 8; ++rp) oft[(((chunk * 8 + w) * 2 + ti) * 8 + rp) * 64 + lane] = pkbf(o[ti][2 * rp], o[ti][2 * rp + 1]);
                } else {
                    SC_WAIT_L0(); SC_BAR();
                    const int et = tid >> 3, epart = tid & 7; bf16* gp = Gh + (row0 + et) * 1024 + epart * 32; v4u gwv[4];
#pragma unroll
                    for (int x = 0; x < 4; ++x) gwv[x] = *(const v4u*)(gp + 8 * x);
#pragma unroll
                    for (int ti = 0; ti < 2; ++ti)
#pragma unroll
                        for (int rp = 0; rp < 8; ++rp) {
                            *(LAS float*)(lds + (32 * ti + crow(2 * rp, h2)) * OPITCH + (32 * w + r) * 4) = o[ti][2 * rp];
                            *(LAS float*)(lds + (32 * ti + crow(2 * rp + 1, h2)) * OPITCH + (32 * w + r) * 4) = o[ti][2 * rp + 1]; }
                    SC_WAIT_L0(); SC_BAR();
                    { const LAS f32x4* op = (const LAS f32x4*)(lds + et * OPITCH + epart * 128);
                      float s1 = 0.f, s2 = 0.f;
#pragma unroll
                      for (int x = 0; x < 8; ++x) { const f32x4 q = op[x]; s1 += (q[0] + q[1]) + (q[2] + q[3]); s2 += (q[0] * q[0] + q[1] * q[1]) + (q[2] * q[2] + q[3] * q[3]); }
#pragma unroll
                      for (int x = 1; x < 8; x <<= 1) { s1 += __shfl_xor(s1, x); s2 += __shfl_xor(s2, x); }
                      const float mu = mixer ? s1 * (1.f / 256.f) : 0.f; const float var = s2 * (1.f / 256.f) - mu * mu; const float rstd = rsqrtf(var + EPS);
                      const LAS f32x4* gnl = (const LAS f32x4*)(lds + SC_GN + epart * 128);
#pragma unroll
                      for (int x = 0; x < 4; ++x) { const unsigned gws[4] = {gwv[x].x, gwv[x].y, gwv[x].z, gwv[x].w}; float y[8];
                          const f32x4 oa = op[2 * x], ob = op[2 * x + 1], na = gnl[2 * x], nb = gnl[2 * x + 1];
#pragma unroll
                          for (int e = 0; e < 8; ++e) { const float ovv = e < 4 ? oa[e & 3] : ob[e & 3]; const float g = (e & 1) ? bfhi(gws[e >> 1]) : bflo(gws[e >> 1]); const float gnv = e < 4 ? na[e & 3] : nb[e & 3];
                              const float yy = (ovv - mu) * rstd * gnv; y[e] = yy * g / (1.f + __expf(-g)); }
                          v4u yw; yw.x = pkbf(y[0], y[1]); yw.y = pkbf(y[2], y[3]); yw.z = pkbf(y[4], y[5]); yw.w = pkbf(y[6], y[7]); if (!dry) *(v4u*)(gp + 8 * x) = yw; else asm volatile("" :: "v"(yw)); } }
                }
                asm volatile("" ::: "memory"); SC_WAIT_L0(); SC_BAR();
            }
        }
    }
}
constexpr int CW_TOFF = 2048;
struct RowMapGU { bf16* base; int e; int up; __device__ __forceinline__ bf16* operator()(int s) const { return base + ((size_t)e * 512 + 8 * (s >> 2) + (s & 3) + 4 * up) * 1024; } };
struct RowMapDn { bf16* base; int e; __device__ __forceinline__ bf16* operator()(int s) const { return base + ((size_t)e * 1024 + s) * 256; } };
__device__ __forceinline__ void p_convert_experts(LAS unsigned char* lds, const float* weg, const float* weu, const float* wed, bf16* E1T, bf16* WdT) {
    int tidx_ = threadIdx.x; asm volatile("" : "+v"(tidx_));
    const int wave = tidx_ >> 6, lane = tidx_ & 63;
    LAS float* scr = (LAS float*)(lds + wave * 12288);
    const int gw = blockIdx.x * 8 + wave, NGW = gridDim.x * 8;
    for (int it = gw; it < 3 * 4096; it += NGW) {
        const int kind = it >> 12, r = it & 4095, e = r >> 7, item = r & 127;
        if (kind == 0) { RowMapGU rm{E1T, e, 0}; cvt_item(weg + (size_t)e * 1024 * 256, 256, scr, item, lane, rm); }
        else if (kind == 1) { RowMapGU rm{E1T, e, 1}; cvt_item(weu + (size_t)e * 1024 * 256, 256, scr, item, lane, rm); }
        else { RowMapDn rm{WdT, e}; cvt_item(wed + (size_t)e * 256 * 1024, 1024, scr, item, lane, rm); }
    }
}
__device__ __forceinline__ void p_dispatch2(LAS unsigned char* lds, int4* route, const unsigned* cnt, unsigned* cur, int* toff_g, const bf16* H2, bf16* H2s) {
    LAS unsigned* off = (LAS unsigned*)lds;
    if (threadIdx.x == 0) { unsigned o = 0; for (int e = 0; e < 32; ++e) { off[e] = o; if (blockIdx.x == 0) toff_g[e] = (int)(o >> 8); o += (cnt[e] + 255u) & ~255u; } off[32] = o; if (blockIdx.x == 0) toff_g[32] = (int)(o >> 8); }
    __syncthreads();
    const int lane = threadIdx.x & 63, gw = blockIdx.x * (NTHR / 64) + (threadIdx.x >> 6), ngw = gridDim.x * (NTHR / 64);
    for (int r = gw; r < T; r += ngw) {
        int4 rt = route[r]; unsigned s0 = 0, s1 = 0;
        if (lane == 0) { s0 = off[rt.x] + atomicAdd(&cur[rt.x], 1u); s1 = off[rt.y] + atomicAdd(&cur[rt.y], 1u); rt.z = (int)s0; rt.w = (int)s1; route[r] = rt; }
        s0 = __shfl(s0, 0); s1 = __shfl(s1, 0);
        const v4u a = *(const v4u*)(H2 + (size_t)r * D + lane * 8), b = *(const v4u*)(H2 + (size_t)r * D + 512 + lane * 8);
        *(v4u*)(H2s + (size_t)s0 * D + lane * 8) = a; *(v4u*)(H2s + (size_t)s0 * D + 512 + lane * 8) = b;
        *(v4u*)(H2s + (size_t)s1 * D + lane * 8) = a; *(v4u*)(H2s + (size_t)s1 * D + 512 + lane * 8) = b;
    }
    __syncthreads();
}
struct MoeOrder {
    int nct, G, c, ntiles; const LAS int* toff;
    __device__ __forceinline__ bool next(int i, Unit& u) const {
        const int Lx = i * G + c; if (Lx >= ntiles * nct) return false;
        const int rt = Lx / nct, ct = Lx - rt * nct; int e = 0; while (__builtin_amdgcn_readfirstlane(toff[e + 1]) <= rt) ++e;
        u.pm = rt; u.pn = __builtin_amdgcn_readfirstlane(e * nct + ct); u.k = 0; return true;
    }
    __device__ __forceinline__ void a_ready(const Unit&) const {}
    __device__ __forceinline__ void done(const Unit&) const {}
    __device__ __forceinline__ const pg8::bf16_t* a_base(const pg8::Gemm& g, const Unit&) const { return g.A; }
    __device__ __forceinline__ const pg8::bf16_t* b_base(const pg8::Gemm& g, const Unit&) const { return g.Bt; }
};
struct EpiHid {
    static constexpr bool PERM = true, AFTER_DRAIN = false;
    bf16* HID;
    __device__ __forceinline__ void operator()(const f32x4 (&acc)[2][2][4][2], const Unit& u, int wr, int wc, int fr, int fq) const {
        const int row0 = u.pm * 256 + wr * 64 + fr, col0 = (u.pn & 1) * 128 + 16 * wc + 4 * fq;
#pragma unroll
        for (int ai = 0; ai < 2; ++ai)
#pragma unroll
            for (int m = 0; m < 4; ++m) { bf16* rowp = HID + (size_t)(row0 + ai * 128 + m * 16) * 256 + col0;
#pragma unroll
                for (int bj = 0; bj < 2; ++bj) { const f32x4 g = acc[ai][bj][m][0], uu = acc[ai][bj][m][1]; float hv[4];
#pragma unroll
                    for (int i = 0; i < 4; ++i) hv[i] = g[i] / (1.f + __expf(-g[i])) * uu[i];
                    v2u w; w.x = pk2(hv[0], hv[1]); w.y = pk2(hv[2], hv[3]); *(v2u*)(rowp + bj * 64) = w; } }
    }
};
struct EpiYs {
    static constexpr bool PERM = true, AFTER_DRAIN = false;
    bf16* YS;
    __device__ __forceinline__ void operator()(const f32x4 (&acc)[2][2][4][2], const Unit& u, int wr, int wc, int fr, int fq) const {
        const int row0 = u.pm * 256 + wr * 64 + fr, col0 = (u.pn & 3) * 256 + wc * 32 + 8 * fq;
#pragma unroll
        for (int ai = 0; ai < 2; ++ai)
#pragma unroll
            for (int m = 0; m < 4; ++m) { bf16* rowp = YS + (size_t)(row0 + ai * 128 + m * 16) * 1024 + col0;
#pragma unroll
                for (int bj = 0; bj < 2; ++bj) { const f32x4 v0 = acc[ai][bj][m][0], v1 = acc[ai][bj][m][1];
                    v4u w; w.x = pk2(v0[0], v0[1]); w.y = pk2(v0[2], v0[3]); w.z = pk2(v1[0], v1[1]); w.w = pk2(v1[2], v1[3]); *(v4u*)(rowp + bj * 128) = w; } }
    }
};
__device__ __forceinline__ void p_final2(const float* H1, const bf16* YS, const int4* route, const float2* rw, const float* ada, const float* gfin, float* out) {
    int tidx_ = threadIdx.x; asm volatile("" : "+v"(tidx_));
    const int lane = tidx_ & 63, gw = blockIdx.x * (NTHR / 64) + (tidx_ >> 6), ngw = gridDim.x * (NTHR / 64);
    for (int r = gw; r < T; r += ngw) {
        const int4 rt = route[r]; const float2 w = rw[r]; const float* g2 = ada + (r / L) * 6144 + 5120;
        float4 v[4]; float ss = 0.f;
#pragma unroll
        for (int j = 0; j < 4; ++j) { const int c = j * 256 + lane * 4;
            const v2u y0 = *(const v2u*)(YS + (size_t)rt.z * 1024 + c), y1 = *(const v2u*)(YS + (size_t)rt.w * 1024 + c); const float4 hh = *(const float4*)(H1 + (size_t)r * D + c), g = *(const float4*)(g2 + c);
            v[j].x = hh.x + g.x * (w.x * bflo(y0.x) + w.y * bflo(y1.x)); v[j].y = hh.y + g.y * (w.x * bfhi(y0.x) + w.y * bfhi(y1.x)); v[j].z = hh.z + g.z * (w.x * bflo(y0.y) + w.y * bflo(y1.y)); v[j].w = hh.w + g.w * (w.x * bfhi(y0.y) + w.y * bfhi(y1.y));
            ss += v[j].x * v[j].x + v[j].y * v[j].y + v[j].z * v[j].z + v[j].w * v[j].w; }
#pragma unroll
        for (int o = 1; o < 64; o <<= 1) ss += __shfl_xor(ss, o);
        const float rstd = rsqrtf(ss * (1.f / D) + EPS);
#pragma unroll
        for (int j = 0; j < 4; ++j) { const int c = j * 256 + lane * 4; const float4 g = *(const float4*)(gfin + c);
            float4 o4; o4.x = v[j].x * rstd * g.x; o4.y = v[j].y * rstd * g.y; o4.z = v[j].z * rstd * g.z; o4.w = v[j].w * rstd * g.w;
            *(float4*)(out + (size_t)r * D + c) = o4; }
    }
}
__device__ __forceinline__ void p_norm_route2(LAS unsigned char* lds, const RouteP& p) {
    int tidx_ = threadIdx.x; asm volatile("" : "+v"(tidx_));
    LAS unsigned* hist = (LAS unsigned*)lds;
    LAS unsigned* base = (LAS unsigned*)(lds + 128);
    LAS int* tokr = (LAS int*)(lds + 256);
    const int tid = tidx_, lane = tid & 63, w = tid >> 6;
    for (int blk = blockIdx.x; blk < T / 64; blk += gridDim.x) {
        if (tid < 32) hist[tid] = 0u;
        __syncthreads();
        for (int i = 0; i < 8; ++i) {
            const int r = blk * 64 + w * 8 + i;
            const float* src = p.H1 + (size_t)r * D; const float* sh = p.ada + (r / L) * 6144 + 3072; const float* sc = sh + 1024;
            float4 v[4]; float ss = 0.f;
#pragma unroll
            for (int j = 0; j < 4; ++j) { v[j] = *(const float4*)(src + j * 256 + lane * 4); ss += v[j].x * v[j].x + v[j].y * v[j].y + v[j].z * v[j].z + v[j].w * v[j].w; }
#pragma unroll
            for (int o = 1; o < 64; o <<= 1) ss += __shfl_xor(ss, o);
            const float rstd = rsqrtf(ss * (1.f / D) + EPS);
            float gl[4] = {0.f, 0.f, 0.f, 0.f};
#pragma unroll
            for (int j = 0; j < 4; ++j) { const int c = j * 256 + lane * 4;
                const float4 g = *(const float4*)(p.gnorm + c), s1 = *(const float4*)(sc + c), s0 = *(const float4*)(sh + c);
                v[j].x = v[j].x * rstd * g.x * (1.f + s1.x) + s0.x; v[j].y = v[j].y * rstd * g.y * (1.f + s1.y) + s0.y; v[j].z = v[j].z * rstd * g.z * (1.f + s1.z) + s0.z; v[j].w = v[j].w * rstd * g.w * (1.f + s1.w) + s0.w;
                uint2 o2; o2.x = (unsigned)f2bf(v[j].x) | ((unsigned)f2bf(v[j].y) << 16); o2.y = (unsigned)f2bf(v[j].z) | ((unsigned)f2bf(v[j].w) << 16);
                *(uint2*)(p.H2 + (size_t)r * D + c) = o2;
                const float yy[4] = {v[j].x, v[j].y, v[j].z, v[j].w};
#pragma unroll
                for (int q = 0; q < 4; ++q) { const float4 wv = *(const float4*)(p.wrg + (size_t)(c + q) * 4); gl[0] += yy[q] * wv.x; gl[1] += yy[q] * wv.y; gl[2] += yy[q] * wv.z; gl[3] += yy[q] * wv.w; } }
#pragma unroll
            for (int g = 0; g < 4; ++g) { float s = gl[g];
#pragma unroll
                for (int o = 1; o < 64; o <<= 1) s += __shfl_xor(s, o); gl[g] = s + p.brg[g]; }
            int gs = 0; float gmax = gl[0];
#pragma unroll
            for (int g = 1; g < 4; ++g) if (gl[g] > gmax) { gmax = gl[g]; gs = g; }
            float den = 0.f;
#pragma unroll
            for (int g = 0; g < 4; ++g) den += expf(gl[g] - gmax);
            const float gwt = 1.f / den;
            float el[8];
#pragma unroll
            for (int e = 0; e < 8; ++e) el[e] = 0.f;
#pragma unroll
            for (int j = 0; j < 4; ++j) { const int c = j * 256 + lane * 4; const float yy[4] = {v[j].x, v[j].y, v[j].z, v[j].w};
#pragma unroll
                for (int q = 0; q < 4; ++q) { const float* wp = p.wre + (size_t)(c + q) * 32 + gs * 8; const float4 w0 = *(const float4*)wp, w1 = *(const float4*)(wp + 4);
                    el[0] += yy[q] * w0.x; el[1] += yy[q] * w0.y; el[2] += yy[q] * w0.z; el[3] += yy[q] * w0.w; el[4] += yy[q] * w1.x; el[5] += yy[q] * w1.y; el[6] += yy[q] * w1.z; el[7] += yy[q] * w1.w; } }
#pragma unroll
            for (int e = 0; e < 8; ++e) { float s = el[e];
#pragma unroll
                for (int o = 1; o < 64; o <<= 1) s += __shfl_xor(s, o); el[e] = s + p.bre[gs * 8 + e]; }
            int i0 = 0; float v0 = el[0];
#pragma unroll
            for (int e = 1; e < 8; ++e) if (el[e] > v0) { v0 = el[e]; i0 = e; }
            int i1 = -1; float v1 = -3.0e38f;
#pragma unroll
            for (int e = 0; e < 8; ++e) if (e != i0 && el[e] > v1) { v1 = el[e]; i1 = e; }
            if (lane == 0) {
                const float w0 = 1.f / (1.f + expf(v1 - v0)), w1 = 1.f - w0;
                const int e0 = gs * 8 + i0, e1 = gs * 8 + i1;
                const unsigned r0 = atomicAdd((unsigned*)&hist[e0], 1u), r1 = atomicAdd((unsigned*)&hist[e1], 1u);
                { LAS int* tp = tokr + (w * 8 + i) * 4; tp[0] = e0; tp[1] = e1; tp[2] = (int)r0; tp[3] = (int)r1; } p.rw[r] = make_float2(w0 * gwt, w1 * gwt);
            }
        }
        __syncthreads();
        if (tid < 32) base[tid] = hist[tid] ? atomicAdd(&p.cnt[tid], hist[tid]) : 0u;
        __syncthreads();
        if (tid < 64) { const LAS int* tp = tokr + tid * 4; const int e0 = tp[0], e1 = tp[1]; p.route[blk * 64 + tid] = make_int4(e0, e1, tp[2] + (int)base[e0], tp[3] + (int)base[e1]); }
        __syncthreads();
    }
}
__device__ __forceinline__ void p_dispatch3(LAS unsigned char* lds, int4* route, const unsigned* cnt, int* toff_g, const bf16* H2, bf16* H2s) {
    int tidx_ = threadIdx.x; asm volatile("" : "+v"(tidx_));
    LAS unsigned* off = (LAS unsigned*)lds;
    if (tidx_ == 0) { unsigned o = 0; for (int e = 0; e < 32; ++e) { off[e] = o; if (blockIdx.x == 0) toff_g[e] = (int)(o >> 8); o += (cnt[e] + 255u) & ~255u; } off[32] = o; if (blockIdx.x == 0) toff_g[32] = (int)(o >> 8); }
    __syncthreads();
    const int lane = tidx_ & 63, gw = blockIdx.x * (NTHR / 64) + (tidx_ >> 6), ngw = gridDim.x * (NTHR / 64);
    for (int r = gw; r < T; r += ngw) {
        int4 rt = route[r]; const unsigned s0 = off[rt.x] + (unsigned)rt.z, s1 = off[rt.y] + (unsigned)rt.w;
        const v4u a = *(const v4u*)(H2 + (size_t)r * D + lane * 8), b = *(const v4u*)(H2 + (size_t)r * D + 512 + lane * 8);
        if (lane == 0) { rt.z = (int)s0; rt.w = (int)s1; route[r] = rt; }
        *(v4u*)(H2s + (size_t)s0 * D + lane * 8) = a; *(v4u*)(H2s + (size_t)s0 * D + 512 + lane * 8) = b;
        *(v4u*)(H2s + (size_t)s1 * D + lane * 8) = a; *(v4u*)(H2s + (size_t)s1 * D + 512 + lane * 8) = b;
    }
    __syncthreads();
}
#ifndef MK_N_LAUNCHES
#define MK_N_LAUNCHES 1
#endif
constexpr int NPHASE = 14;
struct Args { const float* in[23]; float* out; unsigned char* ws; int ph_lo, ph_hi; };
typedef const Args __attribute__((address_space(4))) CArgs;
__device__ __forceinline__ CArgs* kargs_ptr() { CArgs* p = (CArgs*)__builtin_amdgcn_kernarg_segment_ptr(); asm volatile("" : "+s"(p)); return p; }
__global__ void __launch_bounds__(NTHR, 2) mk_fwd(Args a) {
    extern __shared__ __attribute__((aligned(16))) unsigned char lds_raw[];
    LAS unsigned char* lds = (LAS unsigned char*)lds_raw;
    const int tid = threadIdx.x;
#define KA() kargs_ptr()
#define WSB (KA()->ws)
#define OUTB (KA()->out)
#define A_x (KA()->in[0])
#define A_c (KA()->in[1])
#define A_ctx (KA()->in[2])
#define A_cctx (KA()->in[3])
#define A_w_ada (KA()->in[4])
#define A_b_ada (KA()->in[5])
#define A_norm_mix (KA()->in[6])
#define A_norm_ffn (KA()->in[7])
#define A_w_in (KA()->in[8])
#define A_lrw (KA()->in[9])
#define A_lrb (KA()->in[10])
#define A_gla_norm (KA()->in[11])
#define A_wbg (KA()->in[12])
#define A_wbr (KA()->in[13])
#define A_w_out (KA()->in[14])
#define A_wrg (KA()->in[15])
#define A_brg (KA()->in[16])
#define A_wre (KA()->in[17])
#define A_bre (KA()->in[18])
#define A_weg (KA()->in[19])
#define A_weu (KA()->in[20])
#define A_wed (KA()->in[21])
#define A_norm_final (KA()->in[22])
    if (tid < 4) ((LAS unsigned*)(lds + LDS_MISC))[tid] = 0u;
    __syncthreads();
    XcdBarrier bar; bar.bar = (unsigned*)(WSB + WS_CTL) + CW_BAR; bar.x = 0; bar.st = nullptr;
    if (KA()->ph_hi - KA()->ph_lo > 1) bar = xcd_barrier_post((unsigned*)(WSB + WS_CTL) + CW_BAR, (volatile LAS unsigned*)(lds + LDS_MISC));
    const int lo = KA()->ph_lo, hi = KA()->ph_hi;
#ifndef PROBE_DUP
#define PROBE_DUP -1
#endif
#define IN(k) (lo <= (k) && (k) < hi)
#define PHASE(k, ...) if (IN(k)) { if (PROBE_DUP == (k)) { __VA_ARGS__ xcd_barrier(bar); } { __VA_ARGS__ } }
#define SEAM(k) do { if (IN(k) && IN((k) + 1)) xcd_barrier(bar); } while (0)
    PHASE(0, p_ada(lds, A_c, A_cctx, A_w_ada, A_b_ada, ((float*)(WSB + WS_ADA)), ((float2*)(WSB + WS_ROPE))); p_convert_weights(lds, A_w_in, A_wbg, A_wbr, A_w_out, ((bf16*)OUTB), ((bf16*)OUTB + (size_t)6144 * 1024), ((bf16*)(WSB + WS_WINM)), ((bf16*)(WSB + WS_WBG)), ((bf16*)(WSB + WS_WBR)), ((bf16*)(WSB + WS_WOUT)));) SEAM(0);
    PHASE(1, p_norm_mod(A_x, A_ctx, A_norm_mix, ((float*)(WSB + WS_ADA)), ((bf16*)((unsigned char*)OUTB + DO_HL)), 0, TT);) SEAM(1);
    PHASE(2, pg8::Gemm g{((bf16*)((unsigned char*)OUTB + DO_HL)), ((bf16*)OUTB), TT, 6144, 1024}; ProjOrder S; S.init((int)gridDim.x, (int)blockIdx.x);         EpiProjF E{((bf16*)(WSB + WS_GQ)), ((bf16*)(WSB + WS_GK)), ((bf16*)(WSB + WS_GV)), ((bf16*)(WSB + WS_GG)), ((bf16*)(WSB + WS_RQ)), ((bf16*)(WSB + WS_RK)), ((bf16*)(WSB + WS_RV)), ((bf16*)(WSB + WS_RG)), ((float2*)(WSB + WS_ROPE))};         pg8::gemm_phase<EpiProjF, ProjOrder, true, true>(lds, g, S, E);         p_lr(lds, ((bf16*)((unsigned char*)OUTB + DO_HL)), ((bf16*)OUTB + (size_t)6144 * 1024), ((float*)(WSB + WS_LR)));) SEAM(2);
#define SCANBUFS ScanBufs sb{((bf16*)(WSB + WS_GQ)), ((bf16*)(WSB + WS_GK)), ((bf16*)(WSB + WS_GV)), ((bf16*)(WSB + WS_RQ)), ((bf16*)(WSB + WS_RK)), ((bf16*)(WSB + WS_RV)), ((bf16*)(WSB + WS_GG)), ((bf16*)(WSB + WS_RG)), ((float*)(WSB + WS_LR)), A_lrw, A_lrb, A_gla_norm, (unsigned*)(WSB + WS_ST), (float*)(WSB + WS_ST + 33 * MiB), (unsigned*)OUTB};
#ifdef PROBE_P3
    if (IN(3)) { SCANBUFS p_scan_a(lds, sb); xcd_barrier(bar); }
#endif
    if (IN(3)) { SCANBUFS p_scan_a(lds, sb); } SEAM(3);
    if (IN(4)) { SCANBUFS p_scan_b(sb); } SEAM(4);
#ifdef PROBE_P5
    if (IN(5)) { SCANBUFS p_scan_c(lds, sb, true); xcd_barrier(bar); }
#endif
    if (IN(5)) { SCANBUFS p_scan_c(lds, sb); } SEAM(5);
    PHASE(6, p_norm_mod(A_x, A_ctx, A_norm_mix, ((float*)(WSB + WS_ADA)), ((bf16*)OUTB), 0, T); p_convert_experts(lds, A_weg, A_weu, A_wed, ((bf16*)(WSB + WS_EXPW)), ((bf16*)(WSB + WS_EXPW + 32 * MiB)));) SEAM(6);
    PHASE(7, ChainOrder S; S.so.init(T, 1024, (int)gridDim.x, (int)blockIdx.x);
        S.A[0] = ((bf16*)OUTB); S.A[1] = ((bf16*)(WSB + WS_GG)); S.A[2] = ((bf16*)OUTB); S.A[3] = ((bf16*)(WSB + WS_RG));
        S.B[0] = ((bf16*)(WSB + WS_WINM)); S.B[1] = ((bf16*)(WSB + WS_WBG)); S.B[2] = ((bf16*)(WSB + WS_WINM)) + (size_t)1024 * 1024; S.B[3] = ((bf16*)(WSB + WS_WBR));
        pg8::Gemm g{((bf16*)OUTB), ((bf16*)(WSB + WS_WINM)), T, 1024, 1024}; EpiChain E{((bf16*)(WSB + WS_Y)), ((bf16*)(WSB + WS_S2))};
        pg8::gemm_phase<EpiChain, ChainOrder, true, true>(lds, g, S, E);) SEAM(7);
    PHASE(8, pg8::StaticOrder S; S.init(T, 1024, (int)gridDim.x, (int)blockIdx.x); pg8::Gemm g{((bf16*)(WSB + WS_Y)), ((bf16*)(WSB + WS_WOUT)), T, 1024, 1024}; EpiOutF E{A_x, ((float*)(WSB + WS_ADA)), ((float*)OUTB)}; pg8::gemm_phase<EpiOutF, pg8::StaticOrder, false, true>(lds, g, S, E);) SEAM(8);
    if (IN(9)) { RouteP rp{((float*)OUTB), A_norm_ffn, ((float*)(WSB + WS_ADA)), A_wrg, A_brg, A_wre, A_bre, ((bf16*)(WSB + WS_ST)), ((int4*)(WSB + WS_ROUTE)), ((float2*)(WSB + WS_ROUTE + 512 * 1024)), ((unsigned*)(WSB + WS_CTL)) + CW_CNT}; p_norm_route2(lds, rp); } SEAM(9);
    if (IN(10)) { p_dispatch3(lds, ((int4*)(WSB + WS_ROUTE)), ((unsigned*)(WSB + WS_CTL)) + CW_CNT, ((int*)((unsigned*)(WSB + WS_CTL) + CW_TOFF)), ((bf16*)(WSB + WS_ST)), ((bf16*)(WSB + WS_YS))); } SEAM(10);
    if (IN(11) || IN(12)) { if (tid < 33) ((LAS int*)(lds + LDS_MISC + 64))[tid] = ((int*)((unsigned*)(WSB + WS_CTL) + CW_TOFF))[tid]; __syncthreads(); }
    PHASE(11, MoeOrder S{2, (int)gridDim.x, (int)blockIdx.x, ((const LAS int*)(lds + LDS_MISC + 64))[32], (const LAS int*)(lds + LDS_MISC + 64)};         pg8::Gemm g{((bf16*)(WSB + WS_YS)), ((bf16*)(WSB + WS_EXPW)), 0, 0, 1024}; EpiHid E{((bf16*)(WSB + WS_GG))}; pg8::gemm_phase<EpiHid, MoeOrder, true, true>(lds, g, S, E);) SEAM(11);
    PHASE(12, MoeOrder S{4, (int)gridDim.x, (int)blockIdx.x, ((const LAS int*)(lds + LDS_MISC + 64))[32], (const LAS int*)(lds + LDS_MISC + 64)};         int kdn = 256; asm volatile("" : "+s"(kdn));            pg8::Gemm g{((bf16*)(WSB + WS_GG)), ((bf16*)(WSB + WS_EXPW + 32 * MiB)), 0, 0, kdn}; EpiYs E{((bf16*)(WSB + WS_YS))}; pg8::gemm_phase<EpiYs, MoeOrder, true, true>(lds, g, S, E);) SEAM(12);
    if (IN(13)) { p_final2(((float*)OUTB), ((bf16*)(WSB + WS_YS)), ((int4*)(WSB + WS_ROUTE)), ((float2*)(WSB + WS_ROUTE + 512 * 1024)), ((float*)(WSB + WS_ADA)), A_norm_final, ((float*)OUTB)); }
#undef IN
#undef SEAM
}

extern "C" void kernel_launch(void* const* d_in, const int* in_sizes, int n_in, void* d_out, int out_size, void* d_ws, size_t ws_size, hipStream_t stream) {
    static int grid = 0;
    if (grid == 0) {
        if (n_in != 23 || ws_size < WS_END) { fprintf(stderr, "kernel_launch: unexpected n_in %d or ws %zu\n", n_in, ws_size); grid = -1; return; }
        int dev = 0, cus = 0, per_cu = 0;
        if (hipGetDevice(&dev) != hipSuccess || hipDeviceGetAttribute(&cus, hipDeviceAttributeMultiprocessorCount, dev) != hipSuccess) { grid = -1; return; }
        if (hipFuncSetAttribute((const void*)mk_fwd, hipFuncAttributeMaxDynamicSharedMemorySize, LDS_BYTES) != hipSuccess) { fprintf(stderr, "kernel_launch: hipFuncSetAttribute failed\n"); grid = -1; return; }
        if (hipOccupancyMaxActiveBlocksPerMultiprocessor(&per_cu, (const void*)mk_fwd, NTHR, LDS_BYTES) != hipSuccess || per_cu < 1) { fprintf(stderr, "kernel_launch: occupancy query says %d\n", per_cu); }
        (void)hipGetLastError();
        grid = cus;
    }
    if (grid < 0) return;
    if (hipMemsetAsync((char*)d_ws + WS_CTL, 0, 1 * MiB, stream) != hipSuccess) return;
    Args a{};
    for (int i = 0; i < 23; ++i) a.in[i] = (const float*)d_in[i];
    a.out = (float*)d_out; a.ws = (unsigned char*)d_ws;
#if MK_N_LAUNCHES == 1
    a.ph_lo = 0; a.ph_hi = NPHASE;
    hipLaunchKernelGGL(mk_fwd, dim3(grid), dim3(NTHR), LDS_BYTES, stream, a);
#else
    for (int p = 0; p < NPHASE; ++p) { a.ph_lo = p; a.ph_hi = p + 1; hipLaunchKernelGGL(mk_fwd, dim3(grid), dim3(NTHR), LDS_BYTES, stream, a); }
#endif
}
```
